# Optimizing an MI355X kernel written in HIP

```python
import jax, jax.numpy as jnp
from jax import lax
import numpy as np

D_MODEL = 2048
BATCH = 4
SEQ = 2048
DEPTH = 4

N_A = DEPTH // 2
N_B = DEPTH - N_A
D_FF = 4 * D_MODEL
CONV_WIDTH = 3
N_HEADS = 16
QK_NOPE = 128
QK_ROPE = 64
V_HEAD = 128
Q_LORA = 512
KV_LORA = 512
ROPE_THETA = 10000.0
Q_BLOCK = 128
ALPHA = (2 * DEPTH) ** 0.25
BETA = (8 * DEPTH) ** -0.25
LN_EPS = 1e-5
RMS_EPS = 1e-6

kernel_name = "yoco_shortconv_mla_deepnorm"


def layer_norm(x, g, b):
    xf = x.astype(jnp.float32)
    mu = jnp.mean(xf, axis=-1, keepdims=True)
    var = jnp.mean(jnp.square(xf - mu), axis=-1, keepdims=True)
    y = (xf - mu) * lax.rsqrt(var + LN_EPS) * g.astype(jnp.float32) + b.astype(jnp.float32)
    return y.astype(x.dtype)


def rms_norm(x, g):
    xf = x.astype(jnp.float32)
    y = xf * lax.rsqrt(jnp.mean(jnp.square(xf), axis=-1, keepdims=True) + RMS_EPS)
    return (y * g.astype(jnp.float32)).astype(x.dtype)


def rope_tables(seq, dim):
    inv = 1.0 / (ROPE_THETA ** (jnp.arange(0, dim, 2, dtype=jnp.float32) / dim))
    ang = jnp.arange(seq, dtype=jnp.float32)[:, None] * inv[None, :]
    return jnp.cos(ang), jnp.sin(ang)


def apply_rope(x, cos, sin):
    xf = x.astype(jnp.float32)
    half = xf.shape[-1] // 2
    x1, x2 = xf[..., :half], xf[..., half:]
    out = jnp.concatenate([x1 * cos - x2 * sin, x2 * cos + x1 * sin], axis=-1)
    return out.astype(x.dtype)


def short_conv_mixer(x, w_in, conv_w, w_out):
    bcu = x @ w_in
    gate_b, gate_c, u = jnp.split(bcu, 3, axis=-1)
    v = gate_c * u
    y = lax.conv_general_dilated(
        v, conv_w[:, None, :].astype(v.dtype),
        window_strides=(1,), padding=[(CONV_WIDTH - 1, 0)],
        dimension_numbers=("NWC", "WIO", "NWC"), feature_group_count=v.shape[-1])
    return (gate_b * y) @ w_out


def shared_latent_kv(h, w_dkv, kv_norm_g, w_ukv, cos, sin):
    bsz, seq, _ = h.shape
    ckv = h @ w_dkv
    c = rms_norm(ckv[..., :KV_LORA], kv_norm_g)
    k_pe = apply_rope(ckv[..., KV_LORA:], cos, sin)
    kv = (c @ w_ukv).reshape(bsz, seq, N_HEADS, QK_NOPE + V_HEAD)
    return kv[..., :QK_NOPE], k_pe, kv[..., QK_NOPE:]


def mla_mixer(x, w_dq, q_norm_g, w_uq, w_o, k_nope, k_pe, v, cos, sin):
    bsz, seq, _ = x.shape
    q = (rms_norm(x @ w_dq, q_norm_g) @ w_uq).reshape(bsz, seq, N_HEADS, QK_NOPE + QK_ROPE)
    q_nope = q[..., :QK_NOPE]
    q_pe = apply_rope(q[..., QK_NOPE:], cos[:, None, :], sin[:, None, :])
    nb = seq // Q_BLOCK
    scale = (QK_NOPE + QK_ROPE) ** -0.5
    k_pos = jnp.arange(seq)

    def to_blocks(t):
        return jnp.moveaxis(t.reshape(bsz, nb, Q_BLOCK, *t.shape[2:]), 1, 0)

    def attend_block(args):
        qn, qp, blk = args
        s = (jnp.einsum("bqhd,bkhd->bhqk", qn, k_nope)
             + jnp.einsum("bqhr,bkr->bhqk", qp, k_pe)).astype(jnp.float32) * scale
        q_pos = blk * Q_BLOCK + jnp.arange(Q_BLOCK)
        mask = k_pos[None, :] <= q_pos[:, None]
        s = jnp.where(mask[None, None], s, -jnp.inf)
        p = jax.nn.softmax(s, axis=-1).astype(v.dtype)
        return jnp.einsum("bhqk,bkhd->bqhd", p, v)

    o = lax.map(attend_block, (to_blocks(q_nope), to_blocks(q_pe), jnp.arange(nb)))
    o = jnp.moveaxis(o, 0, 1).reshape(bsz, seq, N_HEADS * V_HEAD)
    return o @ w_o


def sq_relu_mlp(x, w1, w2):
    return jnp.square(jax.nn.relu(x @ w1)) @ w2


def setup_inputs(seed: int = 0) -> dict:
    key = jax.random.key(seed)
    ks = jax.random.split(key, 16)
    f32 = jnp.float32

    def dense(k, shape, fan_in, scale=1.0):
        return jax.random.normal(k, shape, f32) * (scale * fan_in ** -0.5)

    return {
        "x": jax.random.normal(ks[0], (BATCH, SEQ, D_MODEL), f32),
        "ln_g": 1.0 + 0.02 * jax.random.normal(ks[1], (DEPTH, 2, D_MODEL), f32),
        "ln_b": 0.02 * jax.random.normal(ks[2], (DEPTH, 2, D_MODEL), f32),
        "conv_w_in": dense(ks[3], (N_A, D_MODEL, 3 * D_MODEL), D_MODEL),
        "conv_w": dense(ks[4], (N_A, CONV_WIDTH, D_MODEL), CONV_WIDTH),
        "conv_w_out": dense(ks[5], (N_A, D_MODEL, D_MODEL), D_MODEL, BETA),
        "kv_w_dkv": dense(ks[6], (D_MODEL, KV_LORA + QK_ROPE), D_MODEL),
        "kv_norm_g": 1.0 + 0.02 * jax.random.normal(ks[7], (KV_LORA,), f32),
        "kv_w_ukv": dense(ks[8], (KV_LORA, N_HEADS * (QK_NOPE + V_HEAD)), KV_LORA),
        "mla_w_dq": dense(ks[9], (N_B, D_MODEL, Q_LORA), D_MODEL),
        "mla_q_norm_g": 1.0 + 0.02 * jax.random.normal(ks[10], (N_B, Q_LORA), f32),
        "mla_w_uq": dense(ks[11], (N_B, Q_LORA, N_HEADS * (QK_NOPE + QK_ROPE)), Q_LORA),
        "mla_w_o": dense(ks[12], (N_B, N_HEADS * V_HEAD, D_MODEL), N_HEADS * V_HEAD, BETA),
        "mlp_w1": dense(ks[13], (DEPTH, D_MODEL, D_FF), D_MODEL),
        "mlp_w2": dense(ks[14], (DEPTH, D_FF, D_MODEL), D_FF, BETA),
    }


def reference(x, ln_g, ln_b, conv_w_in, conv_w, conv_w_out, kv_w_dkv, kv_norm_g,
              kv_w_ukv, mla_w_dq, mla_q_norm_g, mla_w_uq, mla_w_o, mlp_w1, mlp_w2):
    cos, sin = rope_tables(x.shape[1], QK_ROPE)
    h = x
    k_nope = k_pe = v = None
    for layer in range(DEPTH):
        if layer < N_A:
            mix = short_conv_mixer(h, conv_w_in[layer], conv_w[layer], conv_w_out[layer])
        else:
            if layer == N_A:
                k_nope, k_pe, v = shared_latent_kv(h, kv_w_dkv, kv_norm_g, kv_w_ukv, cos, sin)
            j = layer - N_A
            mix = mla_mixer(h, mla_w_dq[j], mla_q_norm_g[j], mla_w_uq[j], mla_w_o[j],
                            k_nope, k_pe, v, cos, sin)
        h = layer_norm(ALPHA * h + mix, ln_g[layer, 0], ln_b[layer, 0])
        h = layer_norm(ALPHA * h + sq_relu_mlp(h, mlp_w1[layer], mlp_w2[layer]),
                       ln_g[layer, 1], ln_b[layer, 1])
    return h
```

```cpp
#include <hip/hip_runtime.h>
#include <hip/hip_cooperative_groups.h>
#include <cstdio>
#include <cstring>
namespace cg = cooperative_groups;

#define LAS __attribute__((address_space(3)))
typedef unsigned short bf16_t;
typedef short bf16x8 __attribute__((ext_vector_type(8)));
typedef float f32x2 __attribute__((ext_vector_type(2)));
typedef float f32x4 __attribute__((ext_vector_type(4)));
typedef float f32x16 __attribute__((ext_vector_type(16)));
typedef unsigned u32x4 __attribute__((ext_vector_type(4)));
typedef unsigned u32x2 __attribute__((ext_vector_type(2)));
typedef __bf16 bf16v2 __attribute__((ext_vector_type(2)));

constexpr int T_TOK = 8192, DM = 2048, DFF = 8192, SEQ = 2048;
constexpr float ALPHA = 1.6817928305074290f;
constexpr float LN_EPS = 1e-5f, RMS_EPS = 1e-6f;
constexpr float QSCALE = 0.07216878364870323f * 1.4426950408889634f;
constexpr int NJOBS = 24;
constexpr int DYN_LDS = 131072 + 16;
#ifndef PH_MASK
#define PH_MASK 0xff
#endif
#ifndef DUP_MASK
#define DUP_MASK 0
#endif
#ifndef DUP_EPI
#define DUP_EPI 0xff
#endif
#ifndef EPI_MASK
#define EPI_MASK 0xff
#endif

__device__ __forceinline__ unsigned pk_bf16(float lo, float hi) {
    bf16v2 v = __builtin_convertvector((f32x2){lo, hi}, bf16v2);
    return __builtin_bit_cast(unsigned, v);
}
__device__ __forceinline__ float bf_lo(unsigned w) { return __uint_as_float(w << 16); }
__device__ __forceinline__ float bf_hi(unsigned w) { return __uint_as_float(w & 0xffff0000u); }

namespace pg8 {
constexpr int BM = 256, BK = 64, HALF = 128, HTB = HALF * BK * 2, STAGE_BYTES = 8 * HTB, NXCD = 8, WGM = 8;
__host__ __device__ __forceinline__ int lds_byte(int r, int c) { const int st = (r >> 4) * 2 + (c >> 5), rr = r & 15, cc = c & 31, ob = rr * 64 + cc * 2; return st * 1024 + (ob ^ (((ob >> 9) & 1) << 5)); }
__host__ __device__ __forceinline__ void stage_rc(int b, int& R, int& C) { const int st = b / 1024, sb = b % 1024, swz = sb ^ (((sb >> 9) & 1) << 5); R = (st >> 1) * 16 + swz / 64; C = (st & 1) * 32 + (swz % 64) / 2; }
__host__ __device__ __forceinline__ int perm32(int rho) { const int n = rho >> 4, i = rho & 15; return 8 * (i >> 2) + 4 * n + (i & 3); }

struct Unit { int pm, pn; };
struct Gemm { const bf16_t* A; const bf16_t* Bt; int M, N, K; };
struct StaticOrder {
    int nM, nN, nwg, G, c;
    __device__ void init(int M, int N, int G_, int c_) { nM = M / BM; nN = N / BM; nwg = nM * nN; G = G_; c = c_; }
    __device__ bool next(int i, Unit& u) const {
        const long L = (long)i * G + c; if (L >= nwg) return false;
        int wgid = (int)L; { const int q = nwg / NXCD, r = nwg % NXCD, xcd = wgid % NXCD, off = wgid / NXCD; wgid = (xcd < r ? xcd * (q + 1) : r * (q + 1) + (xcd - r) * q) + off; }
        const int nig = WGM * nN, gid = wgid / nig, fm = gid * WGM, gsz = (nM - fm) < WGM ? (nM - fm) : WGM;
        u.pm = fm + ((wgid % nig) % gsz); u.pn = (wgid % nig) / gsz; return true;
    }
};

template <class Epi, int K, int LDA = K, int ASPLIT = 0>
__device__ __forceinline__ void gemm_phase(LAS unsigned char* lds, const Gemm g, const StaticOrder& S, const Epi& E) {
    int tid = threadIdx.x; asm volatile("" : "+v"(tid));
    const int wid = __builtin_amdgcn_readfirstlane(tid >> 6), lane = tid & 63, wr = wid >> 2, wc = wid & 3, fr = lane & 15, fq = lane >> 4;
    constexpr int nt = K / BK;
    unsigned voffA[2], voffB[2];
#pragma unroll
    for (int i = 0; i < 2; ++i) { int R, C; stage_rc(tid * 16 + i * 8192, R, C); const int Rb = Epi::PERM ? ((R & ~31) + perm32(R & 31)) : R;
        voffA[i] = (unsigned)(R * LDA + C) * 2u; voffB[i] = (unsigned)(Rb * K + C) * 2u; }
    const size_t kstep = (size_t)(BK * 2);
    const size_t hstep = (size_t)HALF * K * 2;
    const size_t tstep = 2 * hstep;
    const size_t hstepA = (size_t)HALF * LDA * 2;
    const size_t tstepA = 2 * hstepA;
#define PG8_AOFF(u) ((size_t)(u).pm * tstepA + (ASPLIT ? (size_t)((u).pn / (ASPLIT ? ASPLIT : 1)) * K * 2 : (size_t)0))
    const unsigned ldsw = (unsigned)wid * 1024u;
    const int aoff = lds_byte(wr * 64 + fr, fq * 8), boff = lds_byte(wc * 32 + fr, fq * 8);
#define PG8_SA(b, h) (((b) * 2 + (h)) * HTB)
#define PG8_SB(b, h) ((4 + (b) * 2 + (h)) * HTB)
#define PG8_STAGE(bufoff, gbase, voff) do { _Pragma("unroll") for (int _i = 0; _i < 2; ++_i) \
        __builtin_amdgcn_global_load_lds((const unsigned*)((const char*)(gbase) + (voff)[_i]), (LAS unsigned*)(lds + (bufoff) + ldsw + _i * 8192), 16, 0, 0); } while (0)
#define PG8_LDA(dst, b, h) do { _Pragma("unroll") for (int m = 0; m < 4; ++m) _Pragma("unroll") for (int k = 0; k < 2; ++k) dst[m][k] = *(const LAS bf16x8*)(lds + PG8_SA(b, h) + aoff + m * 2048 + k * 1024); } while (0)
#define PG8_LDB(dst, b, h) do { _Pragma("unroll") for (int n = 0; n < 2; ++n) _Pragma("unroll") for (int k = 0; k < 2; ++k) dst[n][k] = *(const LAS bf16x8*)(lds + PG8_SB(b, h) + boff + n * 2048 + k * 1024); } while (0)
#define PG8_MMA(ai, bj, At, Bt) do { __builtin_amdgcn_s_setprio(1); _Pragma("unroll") for (int m = 0; m < 4; ++m) _Pragma("unroll") for (int n = 0; n < 2; ++n) _Pragma("unroll") for (int k = 0; k < 2; ++k) \
        acc[ai][bj][m][n] = __builtin_amdgcn_mfma_f32_16x16x32_bf16(Bt[n][k], At[m][k], acc[ai][bj][m][n], 0, 0, 0); __builtin_amdgcn_s_setprio(0); } while (0)
#define PG8_WAIT_V(n) asm volatile("s_waitcnt vmcnt(" #n ")" ::: "memory")
#define PG8_WAIT_L(n) asm volatile("s_waitcnt lgkmcnt(" #n ")" ::: "memory")
#define PG8_BAR __builtin_amdgcn_s_barrier()
#define PG8_SCHED __builtin_amdgcn_sched_barrier(0)
    Unit cur, nxt; int ui = 0;
    if (!S.next(0, cur)) return;
    f32x4 acc[2][2][4][2];
#pragma unroll
    for (int a = 0; a < 2; ++a)
#pragma unroll
        for (int b = 0; b < 2; ++b)
#pragma unroll
            for (int m = 0; m < 4; ++m)
#pragma unroll
                for (int n = 0; n < 2; ++n) acc[a][b][m][n] = (f32x4){0.f, 0.f, 0.f, 0.f};
    bf16x8 At[4][2], B0[2][2], B1[2][2];
    const char* cA = (const char*)g.A + PG8_AOFF(cur); const char* cB = (const char*)g.Bt + (size_t)cur.pn * tstep;
    PG8_STAGE(PG8_SB(0, 0), cB, voffB); PG8_STAGE(PG8_SA(0, 0), cA, voffA); PG8_STAGE(PG8_SB(0, 1), cB + hstep, voffB); PG8_STAGE(PG8_SA(0, 1), cA + hstepA, voffA);
    if (wr == 1) PG8_BAR;
    PG8_WAIT_V(4); PG8_BAR;
    PG8_STAGE(PG8_SB(1, 0), cB + kstep, voffB); PG8_STAGE(PG8_SA(1, 0), cA + kstep, voffA); PG8_STAGE(PG8_SB(1, 1), cB + hstep + kstep, voffB);
    PG8_WAIT_V(6); PG8_BAR;
    for (;;) {
        const bool has_next = S.next(ui + 1, nxt);
        const char* nA = has_next ? (const char*)g.A + PG8_AOFF(nxt) : cA; const char* nB = has_next ? (const char*)g.Bt + (size_t)nxt.pn * tstep : cB;
        for (int t = 0; t < nt; t += 2) {
            const bool last = (t == nt - 2);
            const char* a1 = cA + (size_t)(t + 1) * kstep;
            const char* a2 = last ? nA : cA + (size_t)(t + 2) * kstep; const char* b2 = last ? nB : cB + (size_t)(t + 2) * kstep;
            const char* a3 = a2 + kstep; const char* b3 = b2 + kstep;
            PG8_LDB(B0, 0, 0); PG8_SCHED; PG8_LDA(At, 0, 0); PG8_STAGE(PG8_SA(1, 1), a1 + hstepA, voffA);
            PG8_WAIT_L(8); PG8_BAR; PG8_WAIT_L(0); PG8_MMA(0, 0, At, B0); PG8_BAR; PG8_SCHED;
            PG8_LDB(B1, 0, 1); PG8_STAGE(PG8_SB(0, 0), b2, voffB);
            PG8_BAR; PG8_WAIT_L(0); PG8_MMA(0, 1, At, B1); PG8_BAR;
            PG8_LDA(At, 0, 1); PG8_STAGE(PG8_SA(0, 0), a2, voffA);
            PG8_BAR; PG8_WAIT_L(0); PG8_MMA(1, 0, At, B0); PG8_BAR; PG8_SCHED;
            PG8_STAGE(PG8_SB(0, 1), b2 + hstep, voffB);
            PG8_WAIT_V(6); PG8_BAR; PG8_MMA(1, 1, At, B1); PG8_BAR;
            PG8_LDB(B0, 1, 0); PG8_SCHED; PG8_LDA(At, 1, 0); PG8_STAGE(PG8_SA(0, 1), a2 + hstepA, voffA);
            PG8_WAIT_L(8); PG8_BAR; PG8_WAIT_L(0); PG8_MMA(0, 0, At, B0); PG8_BAR; PG8_SCHED;
            PG8_LDB(B1, 1, 1); PG8_STAGE(PG8_SB(1, 0), b3, voffB);
            PG8_BAR; PG8_WAIT_L(0); PG8_MMA(0, 1, At, B1); PG8_BAR;
            PG8_LDA(At, 1, 1); PG8_STAGE(PG8_SA(1, 0), a3, voffA);
            PG8_BAR; PG8_WAIT_L(0); PG8_MMA(1, 0, At, B0); PG8_BAR; PG8_SCHED;
            PG8_STAGE(PG8_SB(1, 1), b3 + hstep, voffB);
            PG8_WAIT_V(6); PG8_BAR; PG8_MMA(1, 1, At, B1); PG8_BAR;
        }
        if constexpr (!Epi::AFTER_DRAIN) E(acc, cur, wr, wc, fr, fq);
        if (!has_next) break;
#pragma unroll
        for (int a = 0; a < 2; ++a)
#pragma unroll
            for (int b = 0; b < 2; ++b)
#pragma unroll
                for (int m = 0; m < 4; ++m)
#pragma unroll
                    for (int n = 0; n < 2; ++n) acc[a][b][m][n] = (f32x4){0.f, 0.f, 0.f, 0.f};
        cur = nxt; cA = nA; cB = nB; ++ui;
    }
    PG8_WAIT_V(0);
    if (wr == 0) PG8_BAR;
    PG8_BAR;
    if constexpr (Epi::AFTER_DRAIN) E.fused(acc, cur, wr, wc, fr, fq, lds, wid, lane);
#undef PG8_AOFF
#undef PG8_SA
#undef PG8_SB
#undef PG8_STAGE
#undef PG8_LDA
#undef PG8_LDB
#undef PG8_MMA
#undef PG8_WAIT_V
#undef PG8_WAIT_L
#undef PG8_BAR
#undef PG8_SCHED
}
}
using pg8::Unit;
typedef f32x4 AccT[2][2][4][2];

struct EpiWin {
    static constexpr int ID = 1;
    static constexpr bool PERM = true, AFTER_DRAIN = false;
    bf16_t* gb; bf16_t* vv;
    __device__ __forceinline__ void operator()(const AccT& acc, const Unit& u, int wr, int wc, int fr, int fq) const {
        const int row0 = u.pm * 256 + wr * 64 + fr, cb = wc * 32 + 8 * fq;
        if (u.pn < 8) {
#pragma unroll
            for (int ai = 0; ai < 2; ++ai)
#pragma unroll
                for (int m = 0; m < 4; ++m) { bf16_t* rowp = gb + (size_t)(row0 + ai * 128 + m * 16) * DM + u.pn * 256 + cb;
#pragma unroll
                    for (int bj = 0; bj < 2; ++bj) { const f32x4 v0 = acc[ai][bj][m][0], v1 = acc[ai][bj][m][1];
                        u32x4 w; w.x = pk_bf16(v0[0], v0[1]); w.y = pk_bf16(v0[2], v0[3]); w.z = pk_bf16(v1[0], v1[1]); w.w = pk_bf16(v1[2], v1[3]);
                        *(u32x4*)(rowp + bj * 128) = w; } }
        } else {
            const int j = u.pn - 8;
#pragma unroll
            for (int ai = 0; ai < 2; ++ai)
#pragma unroll
                for (int m = 0; m < 4; ++m) { bf16_t* rowp = vv + (size_t)(row0 + ai * 128 + m * 16) * DM + j * 128 + cb;
                    const f32x4 v0 = acc[ai][0][m][0] * acc[ai][1][m][0], v1 = acc[ai][0][m][1] * acc[ai][1][m][1];
                    u32x4 w; w.x = pk_bf16(v0[0], v0[1]); w.y = pk_bf16(v0[2], v0[3]); w.z = pk_bf16(v1[0], v1[1]); w.w = pk_bf16(v1[2], v1[3]);
                    *(u32x4*)rowp = w; }
        }
    }
};
struct EpiZ {
    static constexpr int ID = 2;
    static constexpr bool PERM = false, AFTER_DRAIN = false;
    const float* res; float* z;
    __device__ __forceinline__ void operator()(const AccT& acc, const Unit& u, int wr, int wc, int fr, int fq) const {
        const int row0 = u.pm * 256 + wr * 64 + fr, col0 = u.pn * 256 + wc * 32 + 4 * fq;
#pragma unroll
        for (int ai = 0; ai < 2; ++ai)
#pragma unroll
            for (int m = 0; m < 4; ++m) { const size_t off = (size_t)(row0 + ai * 128 + m * 16) * DM + col0;
#pragma unroll
                for (int bj = 0; bj < 2; ++bj)
#pragma unroll
                    for (int n = 0; n < 2; ++n) { const f32x4 r = *(const f32x4*)(res + off + bj * 128 + n * 16);
                        *(f32x4*)(z + off + bj * 128 + n * 16) = r * ALPHA + acc[ai][bj][m][n]; }
                asm volatile("" ::: "memory"); }
    }
};
struct EpiRelu2 {
    static constexpr int ID = 4;
    static constexpr bool PERM = true, AFTER_DRAIN = false;
    bf16_t* o;
    __device__ __forceinline__ void operator()(const AccT& acc, const Unit& u, int wr, int wc, int fr, int fq) const {
        const int row0 = u.pm * 256 + wr * 64 + fr, col0 = u.pn * 256 + wc * 32 + 8 * fq;
#pragma unroll
        for (int ai = 0; ai < 2; ++ai)
#pragma unroll
            for (int m = 0; m < 4; ++m) { bf16_t* rowp = o + (size_t)(row0 + ai * 128 + m * 16) * DFF + col0;
#pragma unroll
                for (int bj = 0; bj < 2; ++bj) { f32x4 v0 = acc[ai][bj][m][0], v1 = acc[ai][bj][m][1];
#pragma unroll
                    for (int e = 0; e < 4; ++e) { const float a = fmaxf(v0[e], 0.f), b = fmaxf(v1[e], 0.f); v0[e] = a * a; v1[e] = b * b; }
                    u32x4 w; w.x = pk_bf16(v0[0], v0[1]); w.y = pk_bf16(v0[2], v0[3]); w.z = pk_bf16(v1[0], v1[1]); w.w = pk_bf16(v1[2], v1[3]);
                    *(u32x4*)(rowp + bj * 128) = w; } }
    }
};
template <int ldc> struct EpiF32 {
    static constexpr int ID = 8;
    static constexpr bool PERM = false, AFTER_DRAIN = false;
    float* C;
    __device__ __forceinline__ void operator()(const AccT& acc, const Unit& u, int wr, int wc, int fr, int fq) const {
        const int row0 = u.pm * 256 + wr * 64 + fr, col0 = u.pn * 256 + wc * 32 + 4 * fq;
#pragma unroll
        for (int ai = 0; ai < 2; ++ai)
#pragma unroll
            for (int m = 0; m < 4; ++m) { float* rowp = C + (size_t)(row0 + ai * 128 + m * 16) * ldc + col0;
#pragma unroll
                for (int bj = 0; bj < 2; ++bj)
#pragma unroll
                    for (int n = 0; n < 2; ++n) *(f32x4*)(rowp + bj * 128 + n * 16) = acc[ai][bj][m][n]; }
    }
};
template <int ldc> struct EpiBf16 {
    static constexpr int ID = 16;
    static constexpr bool PERM = true, AFTER_DRAIN = false;
    bf16_t* o;
    __device__ __forceinline__ void operator()(const AccT& acc, const Unit& u, int wr, int wc, int fr, int fq) const {
        const int row0 = u.pm * 256 + wr * 64 + fr, col0 = u.pn * 256 + wc * 32 + 8 * fq;
#pragma unroll
        for (int ai = 0; ai < 2; ++ai)
#pragma unroll
            for (int m = 0; m < 4; ++m) { bf16_t* rowp = o + (size_t)(row0 + ai * 128 + m * 16) * ldc + col0;
#pragma unroll
                for (int bj = 0; bj < 2; ++bj) { const f32x4 v0 = acc[ai][bj][m][0], v1 = acc[ai][bj][m][1];
                    u32x4 w; w.x = pk_bf16(v0[0], v0[1]); w.y = pk_bf16(v0[2], v0[3]); w.z = pk_bf16(v1[0], v1[1]); w.w = pk_bf16(v1[2], v1[3]);
                    *(u32x4*)(rowp + bj * 128) = w; } }
    }
};
struct EpiQ {
    static constexpr int ID = 32;
    static constexpr bool PERM = true, AFTER_DRAIN = false;
    bf16_t* o; const float* cosT; const float* sinT;
    __device__ __forceinline__ void operator()(const AccT& acc, const Unit& u, int wr, int wc, int fr, int fq) const {
        const int row0 = u.pm * 256 + wr * 64 + fr, col0 = u.pn * 256 + wc * 32 + 8 * fq;
        if (u.pn < 8) {
#pragma unroll
            for (int ai = 0; ai < 2; ++ai)
#pragma unroll
                for (int m = 0; m < 4; ++m) { bf16_t* rowp = o + (size_t)(row0 + ai * 128 + m * 16) * 3072 + col0;
#pragma unroll
                    for (int bj = 0; bj < 2; ++bj) { const f32x4 v0 = acc[ai][bj][m][0] * QSCALE, v1 = acc[ai][bj][m][1] * QSCALE;
                        u32x4 w; w.x = pk_bf16(v0[0], v0[1]); w.y = pk_bf16(v0[2], v0[3]); w.z = pk_bf16(v1[0], v1[1]); w.w = pk_bf16(v1[2], v1[3]);
                        *(u32x4*)(rowp + bj * 128) = w; } }
        } else {
#pragma unroll
            for (int ai = 0; ai < 2; ++ai)
#pragma unroll
                for (int m = 0; m < 4; ++m) { const int row = row0 + ai * 128 + m * 16; const int pos = row & (SEQ - 1);
                    bf16_t* rowp = o + (size_t)row * 3072 + col0;
#pragma unroll
                    for (int bj = 0; bj < 2; ++bj) { const int p0 = (col0 + bj * 128) & 63, j = p0 >> 3;
                        const f32x4 cs = *(const f32x4*)(cosT + pos * 32 + 4 * j) * QSCALE, sn = *(const f32x4*)(sinT + pos * 32 + 4 * j) * QSCALE;
                        const f32x4 x1 = acc[ai][bj][m][0], x2 = acc[ai][bj][m][1];
                        const f32x4 v0 = x1 * cs - x2 * sn, v1 = x2 * cs + x1 * sn;
                        u32x4 w; w.x = pk_bf16(v0[0], v0[1]); w.y = pk_bf16(v0[2], v0[3]); w.z = pk_bf16(v1[0], v1[1]); w.w = pk_bf16(v1[2], v1[3]);
                        *(u32x4*)(rowp + bj * 128) = w; } }
        }
    }
};


struct EpiZLn {
    static constexpr int ID = 2;
    static constexpr bool PERM = true, AFTER_DRAIN = true;
    const bf16_t* res; const float* g; const float* b; float* hout; bf16_t* hb; unsigned long long* xbuf; unsigned* cnt;
    __device__ __forceinline__ void fused(AccT& acc, const Unit& u, int wr, int wc, int fr, int fq, LAS unsigned char* lds, int wid, int lane) const {
        LAS f32x2* P = (LAS f32x2*)lds;
        LAS f32x2* S = (LAS f32x2*)(lds + 8192);
        const int row0 = u.pm * 256 + wr * 64 + fr, col0 = u.pn * 256 + wc * 32 + 8 * fq;
#pragma unroll
        for (int ai = 0; ai < 2; ++ai) {
            u32x4 rr[4][2];
#pragma unroll
            for (int m = 0; m < 4; ++m) { const size_t off = (size_t)(row0 + ai * 128 + m * 16) * DM + col0;
#pragma unroll
                for (int bj = 0; bj < 2; ++bj) rr[m][bj] = *(const u32x4*)(res + off + bj * 128); }
            asm volatile("" : "+v"(rr[0][0]), "+v"(rr[0][1]), "+v"(rr[1][0]), "+v"(rr[1][1]), "+v"(rr[2][0]), "+v"(rr[2][1]), "+v"(rr[3][0]), "+v"(rr[3][1]));
#pragma unroll
            for (int m = 0; m < 4; ++m) {
#pragma unroll
                for (int bj = 0; bj < 2; ++bj) { const u32x4 r = rr[m][bj];
                    acc[ai][bj][m][0] = (f32x4){bf_lo(r.x), bf_hi(r.x), bf_lo(r.y), bf_hi(r.y)} * ALPHA + acc[ai][bj][m][0];
                    acc[ai][bj][m][1] = (f32x4){bf_lo(r.z), bf_hi(r.z), bf_lo(r.w), bf_hi(r.w)} * ALPHA + acc[ai][bj][m][1]; }
                asm volatile("" : "+v"(acc[ai][0][m][0]), "+v"(acc[ai][0][m][1]), "+v"(acc[ai][1][m][0]), "+v"(acc[ai][1][m][1])); }
        }
        f32x4 gq[2][2], bq[2][2];
#pragma unroll
        for (int bj = 0; bj < 2; ++bj) { gq[bj][0] = *(const f32x4*)(g + col0 + bj * 128); gq[bj][1] = *(const f32x4*)(g + col0 + bj * 128 + 4); bq[bj][0] = *(const f32x4*)(b + col0 + bj * 128); bq[bj][1] = *(const f32x4*)(b + col0 + bj * 128 + 4); }
#pragma unroll
        for (int ai = 0; ai < 2; ++ai)
#pragma unroll
            for (int m = 0; m < 4; ++m) {
                float sm = 0.f;
#pragma unroll
                for (int bj = 0; bj < 2; ++bj)
#pragma unroll
                    for (int n = 0; n < 2; ++n) { const f32x4 x = acc[ai][bj][m][n]; sm += (x[0] + x[1]) + (x[2] + x[3]); }
                sm += __shfl_xor(sm, 16); sm += __shfl_xor(sm, 32);
                const float mw = sm * (1.0f / 64.0f); float q = 0.f;
#pragma unroll
                for (int bj = 0; bj < 2; ++bj)
#pragma unroll
                    for (int n = 0; n < 2; ++n) { const f32x4 d = acc[ai][bj][m][n] - mw; q += (d[0] * d[0] + d[1] * d[1]) + (d[2] * d[2] + d[3] * d[3]); }
                q += __shfl_xor(q, 16); q += __shfl_xor(q, 32);
                if (fq == 0) P[(ai * 128 + wr * 64 + m * 16 + fr) * 4 + wc] = (f32x2){mw, q};
            }
        asm volatile("s_waitcnt lgkmcnt(0)" ::: "memory"); __builtin_amdgcn_s_barrier(); asm volatile("" ::: "memory");
        const int row = wid * 32 + (lane & 31);
        if (lane < 32) {
            const f32x2 a = P[row * 4 + 0], bq = P[row * 4 + 1], c = P[row * 4 + 2], d = P[row * 4 + 3];
            const float mt = (a.x + bq.x + c.x + d.x) * 0.25f;
            const float da = a.x - mt, db = bq.x - mt, dc = c.x - mt, dd = d.x - mt;
            const float m2 = (a.y + bq.y) + (c.y + d.y) + 64.0f * ((da * da + db * db) + (dc * dc + dd * dd));
            unsigned long long* slot = xbuf + ((size_t)(u.pm * 256 + row) * 8 + u.pn);
            __hip_atomic_store(slot, ((unsigned long long)__float_as_uint(m2) << 32) | __float_as_uint(mt), __ATOMIC_RELAXED, __HIP_MEMORY_SCOPE_AGENT);
        }
        asm volatile("s_waitcnt vmcnt(0)" ::: "memory");
        if (lane == 0) __hip_atomic_fetch_add(cnt + 64 * u.pm, 1u, __ATOMIC_RELAXED, __HIP_MEMORY_SCOPE_AGENT);
        if (wid == 0) {
            unsigned sp = 0;
            while ((unsigned)__builtin_amdgcn_readfirstlane(__hip_atomic_load(cnt + 64 * u.pm, __ATOMIC_RELAXED, __HIP_MEMORY_SCOPE_AGENT)) < 64u) {
                __builtin_amdgcn_s_sleep(1); if (++sp > (1u << 22)) break; }
            __builtin_amdgcn_fence(__ATOMIC_ACQUIRE, "agent");
        }
        asm volatile("s_waitcnt vmcnt(0) lgkmcnt(0)" ::: "memory"); __builtin_amdgcn_s_barrier(); asm volatile("" ::: "memory");
        if (lane < 32) {
            const unsigned long long* slot = xbuf + (size_t)(u.pm * 256 + row) * 8; float mt[8], m2[8]; float ms = 0.f;
#pragma unroll
            for (int t = 0; t < 8; ++t) { const unsigned long long w = __hip_atomic_load(slot + t, __ATOMIC_RELAXED, __HIP_MEMORY_SCOPE_AGENT); mt[t] = __uint_as_float((unsigned)w); m2[t] = __uint_as_float((unsigned)(w >> 32)); ms += mt[t]; }
            const float mean = ms * 0.125f; float q = 0.f;
#pragma unroll
            for (int t = 0; t < 8; ++t) { const float dm = mt[t] - mean; q += m2[t] + 256.0f * dm * dm; }
            S[row] = (f32x2){mean, rsqrtf(q * (1.0f / DM) + LN_EPS)};
        }
        asm volatile("s_waitcnt lgkmcnt(0)" ::: "memory"); __builtin_amdgcn_s_barrier(); asm volatile("" ::: "memory");
#pragma unroll
        for (int bj = 0; bj < 2; ++bj) {
            const f32x4 g0 = gq[bj][0], g1 = gq[bj][1], b0 = bq[bj][0], b1 = bq[bj][1];
#pragma unroll
            for (int ai = 0; ai < 2; ++ai)
#pragma unroll
                for (int m = 0; m < 4; ++m) { const int r = ai * 128 + wr * 64 + m * 16 + fr; const f32x2 sr = S[r]; const size_t off = (size_t)(u.pm * 256 + r) * DM + col0 + bj * 128;
                    const f32x4 y0 = (acc[ai][bj][m][0] - sr.x) * sr.y * g0 + b0, y1 = (acc[ai][bj][m][1] - sr.x) * sr.y * g1 + b1;
                    if (hout) { *(f32x4*)(hout + off) = y0; *(f32x4*)(hout + off + 4) = y1; }
                    else { u32x4 w; w.x = pk_bf16(y0[0], y0[1]); w.y = pk_bf16(y0[2], y0[3]); w.z = pk_bf16(y1[0], y1[1]); w.w = pk_bf16(y1[2], y1[3]); *(u32x4*)(hb + off) = w; } }
            asm volatile("" ::: "memory"); }
    }
};

template <int M, int N, int K, class Epi>
__device__ __forceinline__ void run_gemm(LAS unsigned char* lds, const bf16_t* A, const bf16_t* Bt, const Epi& E) {
    pg8::Gemm g{A, Bt, M, N, K}; pg8::StaticOrder S; S.init(M, N, (int)gridDim.x, (int)blockIdx.x);
    if constexpr ((PH_MASK & 8) && (EPI_MASK & Epi::ID)) pg8::gemm_phase<Epi, K>(lds, g, S, E);
    if constexpr ((DUP_MASK & 8) && (DUP_EPI & Epi::ID)) pg8::gemm_phase<Epi, K>(lds, g, S, E);
}


#define XB_TMO      128
#define XB_XCNT(j)  (256  + 64 * (j))
#define XB_XSUB(j)  (1280 + 64 * (j))
#define XB_XGEN(j)  (2304 + 64 * (j))
#define XB_TOP      3328
#define XB_TOPGEN   3392
#define XCD_BAR_WORDS 3456
#define XB_SPIN_CAP (1u << 22)
__device__ __forceinline__ unsigned xb_ld(unsigned* p)              { return __hip_atomic_load(p, __ATOMIC_RELAXED, __HIP_MEMORY_SCOPE_AGENT); }
__device__ __forceinline__ unsigned xb_add(unsigned* p, unsigned v) { return __hip_atomic_fetch_add(p, v, __ATOMIC_RELAXED, __HIP_MEMORY_SCOPE_AGENT); }
__device__ __forceinline__ unsigned xb_xcc_id() { return (unsigned)__builtin_amdgcn_s_getreg((3 << 11) | 20) & 0xFu; }
#define XB_SPIN(cond, bar) do { unsigned _sp = 0; while (cond) { __builtin_amdgcn_s_sleep(1); \
    if ((++_sp & 255u) == 0u) { if (xb_ld(&(bar)[XB_TMO])) break; if (_sp > XB_SPIN_CAP) { atomicAdd(&(bar)[XB_TMO], 1u); break; } } } } while (0)
struct XcdBarrier { unsigned* bar; unsigned x; volatile LAS unsigned* st; };
__device__ __forceinline__ XcdBarrier xcd_barrier_post(unsigned* bar, volatile LAS unsigned* st) {
    XcdBarrier b; b.bar = bar; b.x = xb_xcc_id(); b.st = st;
    if (threadIdx.x == 0) (void)xb_add(&bar[XB_XCNT(b.x)], 1u);
    return b;
}
__device__ __forceinline__ void xcd_barrier_complete(unsigned* bar, unsigned x, unsigned& nloc, unsigned& nx) {
    const unsigned G = gridDim.x * gridDim.y * gridDim.z;
    unsigned sum, cnt, mine, sp = 0u;
    for (;;) {
        sum = 0u; cnt = 0u; mine = 0u;
#pragma unroll
        for (unsigned j = 0; j < 16; ++j) { const unsigned c = xb_ld(&bar[XB_XCNT(j)]); sum += c; cnt += (c > 0u) ? 1u : 0u; mine = (j == x) ? c : mine; }
        if (sum == G) break;
        __builtin_amdgcn_s_sleep(1);
        if ((++sp & 255u) == 0u) { if (xb_ld(&bar[XB_TMO])) break; if (sp > XB_SPIN_CAP) { atomicAdd(&bar[XB_TMO], 1u); break; } }
    }
    nloc = mine > 0u ? mine : 1u; nx = cnt > 0u ? cnt : 1u;
}
__device__ __forceinline__ void xcd_barrier(const XcdBarrier& b) {
    asm volatile("s_waitcnt vmcnt(0)" ::: "memory");
    __syncthreads();
    if (threadIdx.x == 0) {
        unsigned* bar = b.bar;
        __builtin_amdgcn_s_waitcnt(0);
        unsigned nloc = b.st[0], nx = b.st[1];
        if (nloc == 0u) { xcd_barrier_complete(bar, b.x, nloc, nx); b.st[0] = nloc; b.st[1] = nx; }
        const unsigned old = xb_add(&bar[XB_XSUB(b.x)], 1u);
        const unsigned gen = old / nloc;
        if (old + 1u == (gen + 1u) * nloc) {
            __builtin_amdgcn_fence(__ATOMIC_RELEASE, "agent");
            asm volatile("s_waitcnt vmcnt(0)" ::: "memory");
            const unsigned og = xb_add(&bar[XB_TOP], 1u);
            const unsigned tg = og / nx;
            if (og + 1u == (tg + 1u) * nx) xb_add(&bar[XB_TOPGEN], 1u);
            else XB_SPIN(xb_ld(&bar[XB_TOPGEN]) == tg, bar);
            __builtin_amdgcn_fence(__ATOMIC_ACQUIRE, "agent");
            xb_add(&bar[XB_XGEN(b.x)], 1u);
            asm volatile("s_waitcnt vmcnt(0)" ::: "memory");
        } else {
            XB_SPIN(xb_ld(&bar[XB_XGEN(b.x)]) == gen, bar);
            __builtin_amdgcn_fence(__ATOMIC_ACQUIRE, "agent");
            asm volatile("s_waitcnt vmcnt(0)" ::: "memory");
        }
    }
    __syncthreads();
}

struct Job { const float* src; bf16_t* dst; int K, pitch, ntn, type, tstart, pad; };
struct Params {
    const float* x; const float* ln_g; const float* ln_b; const float* conv_w; const float* kv_norm_g; const float* q_norm_g;
    float* out;
    bf16_t* win; bf16_t* wout; bf16_t* wdqkv; bf16_t* wdq3; bf16_t* wk; bf16_t* wv; bf16_t* wuq; bf16_t* wo; bf16_t* w1; bf16_t* w2;
    bf16_t* hb; float* ha; float* z; bf16_t* a1; bf16_t* gb; bf16_t* vv; bf16_t* gg; bf16_t* qb; bf16_t* ob;
    unsigned* bar; unsigned long long cg_flag; unsigned long long* xbuf; unsigned* lncnt;
    float* cqkv; bf16_t* cqn; bf16_t* ckv; bf16_t* kpe; bf16_t* kn; bf16_t* vt; float* cosT; float* sinT;
    Job jobs[NJOBS];
};

__device__ __forceinline__ int permcol(int type, int n) {
    if (type == 1) { if (n < 2048) return n; const int r = n - 2048, t = r >> 8, w = r & 255, bj = w >> 7; return 2048 + bj * 2048 + t * 128 + (w & 127); }
    if (type == 2) { if (n < 2048) return (n >> 7) * 192 + (n & 127); const int r = n - 2048, hd = r >> 6, p = r & 63, j = p >> 3, e = p & 7;
        const int dim = e < 4 ? 4 * j + e : 32 + 4 * j + (e - 4); return hd * 192 + 128 + dim; }
    if (type == 3) return (n >> 7) * 256 + (n & 127);
    if (type == 4) return (n >> 7) * 256 + 128 + (n & 127);
    return n;
}

__device__ __forceinline__ void convert_phase(const Params& p, LAS unsigned char* lds) {
    int tid = threadIdx.x; asm volatile("" : "+v"(tid));
    LAS bf16_t* Tt = (LAS bf16_t*)lds;
    {
        const int total = p.jobs[NJOBS - 1].tstart + p.jobs[NJOBS - 1].ntn * (p.jobs[NJOBS - 1].K >> 8);
        for (int gtile = blockIdx.x; gtile < total; gtile += gridDim.x) {
            int j = 0;
#pragma unroll 1
            for (int jj = 1; jj < NJOBS; ++jj) if (gtile >= p.jobs[jj].tstart) j = jj;
            const float* src = p.jobs[j].src; bf16_t* dst = p.jobs[j].dst; const int K = p.jobs[j].K, pitch = p.jobs[j].pitch, type = p.jobs[j].type;
            const int ntk = K >> 8, t = gtile - p.jobs[j].tstart;
            const int tn = t / ntk, tk = t - tn * ntk, n0 = tn * 64, k0 = tk * 256;
            const int c4 = tid & 15, kk = tid >> 4;
            const int col = permcol(type, n0 + 4 * c4);
            f32x4 v[8];
#pragma unroll
            for (int i = 0; i < 8; ++i) v[i] = __builtin_nontemporal_load((const f32x4*)(src + (size_t)(k0 + kk + 32 * i) * pitch + col));
#pragma unroll
            for (int i = 0; i < 8; ++i) { const int k = kk + 32 * i;
                const unsigned w0 = pk_bf16(v[i][0], v[i][1]), w1 = pk_bf16(v[i][2], v[i][3]);
                Tt[(4 * c4 + 0) * 264 + k] = (bf16_t)(w0 & 0xffffu); Tt[(4 * c4 + 1) * 264 + k] = (bf16_t)(w0 >> 16);
                Tt[(4 * c4 + 2) * 264 + k] = (bf16_t)(w1 & 0xffffu); Tt[(4 * c4 + 3) * 264 + k] = (bf16_t)(w1 >> 16); }
            __syncthreads();
#pragma unroll
            for (int i = 0; i < 4; ++i) { const int c = tid + 512 * i, nn = c >> 5, kc = c & 31; const u32x4 w = *(const LAS u32x4*)(Tt + nn * 264 + 8 * kc);
              *(u32x4*)(dst + (size_t)(n0 + nn) * K + k0 + 8 * kc) = w; }
            __syncthreads();
        }
    }
    const size_t gt = (size_t)blockIdx.x * 512 + tid, gs = (size_t)gridDim.x * 512;
    for (size_t i = gt; i < (size_t)T_TOK * DM / 8; i += 4 * gs) {
        f32x4 xa[4], xb[4];
#pragma unroll
        for (int u = 0; u < 4; ++u) { size_t ii = i + u * gs; if (ii >= (size_t)T_TOK * DM / 8) ii = i; xa[u] = __builtin_nontemporal_load((const f32x4*)(p.x + ii * 8)); xb[u] = __builtin_nontemporal_load((const f32x4*)(p.x + ii * 8 + 4)); }
        asm volatile("" : "+v"(xa[0]), "+v"(xa[1]), "+v"(xa[2]), "+v"(xa[3]), "+v"(xb[0]), "+v"(xb[1]), "+v"(xb[2]), "+v"(xb[3]));
#pragma unroll
        for (int u = 0; u < 4; ++u) { size_t ii = i + u * gs; if (ii >= (size_t)T_TOK * DM / 8) ii = i; const f32x4 a = xa[u], b = xb[u];
            u32x4 w; w.x = pk_bf16(a[0], a[1]); w.y = pk_bf16(a[2], a[3]); w.z = pk_bf16(b[0], b[1]); w.w = pk_bf16(b[2], b[3]); *(u32x4*)(p.hb + ii * 8) = w; }
    }
    for (size_t i = gt; i < (size_t)192 * DM / 8; i += gs) *(u32x4*)(p.wdqkv + (size_t)1088 * DM + i * 8) = (u32x4){0u, 0u, 0u, 0u};
    for (size_t i = gt; i < (size_t)SEQ * 32; i += gs) { const int pos = (int)(i >> 5), fi = (int)(i & 31);
        const float inv = 1.0f / powf(10000.0f, (float)(2 * fi) / 64.0f); const float ang = (float)pos * inv;
        double rev = (double)ang * 0.15915494309189535; rev -= rint(rev); const float fr = (float)rev;
        p.cosT[i] = __builtin_amdgcn_cosf(fr); p.sinT[i] = __builtin_amdgcn_sinf(fr); }
}

__device__ __forceinline__ float wave_sum(float v) {
#pragma unroll
    for (int o = 32; o >= 1; o >>= 1) v += __shfl_xor(v, o);
    return v;
}

__device__ __forceinline__ void ln_phase(const float* z, const float* g, const float* b, float* hout, bf16_t* hb) {
    int tid = threadIdx.x; asm volatile("" : "+v"(tid));
    const int wid = tid >> 6, lane = tid & 63;
    for (int row = blockIdx.x * 8 + wid; row < T_TOK; row += gridDim.x * 8) {
        const float* zr = z + (size_t)row * DM;
        f32x4 v[8]; float s = 0.f;
#pragma unroll
        for (int i = 0; i < 8; ++i) { v[i] = *(const f32x4*)(zr + 4 * lane + 256 * i); s += (v[i][0] + v[i][1]) + (v[i][2] + v[i][3]); }
        const float mu = wave_sum(s) * (1.0f / DM);
        float q = 0.f;
#pragma unroll
        for (int i = 0; i < 8; ++i) { const f32x4 d = v[i] - mu; q += (d[0] * d[0] + d[1] * d[1]) + (d[2] * d[2] + d[3] * d[3]); }
        const float rstd = rsqrtf(wave_sum(q) * (1.0f / DM) + LN_EPS);
#pragma unroll
        for (int i = 0; i < 8; ++i) { const int col = 4 * lane + 256 * i; const f32x4 gv = *(const f32x4*)(g + col), bv = *(const f32x4*)(b + col);
            const f32x4 y = (v[i] - mu) * rstd * gv + bv;
            if (hout) *(f32x4*)(hout + (size_t)row * DM + col) = y;
            if (hb) { u32x2 w; w.x = pk_bf16(y[0], y[1]); w.y = pk_bf16(y[2], y[3]); *(u32x2*)(hb + (size_t)row * DM + col) = w; } }
    }
}

__device__ __forceinline__ void conv_phase(const bf16_t* gb, const bf16_t* vv, const float* cw, bf16_t* out) {
    int tid = threadIdx.x; asm volatile("" : "+v"(tid));
    const int cgp = tid & 255, rr = tid >> 8;
    float w0[8], w1[8], w2[8];
#pragma unroll
    for (int e = 0; e < 8; ++e) { w0[e] = cw[cgp * 8 + e]; w1[e] = cw[DM + cgp * 8 + e]; w2[e] = cw[2 * DM + cgp * 8 + e]; }
    for (int it = blockIdx.x; it < T_TOK / 32; it += gridDim.x) {
        const int t0 = it * 32 + rr * 16;
        float p2[8], p1[8];
        if ((t0 & (SEQ - 1)) == 0) {
#pragma unroll
            for (int e = 0; e < 8; ++e) { p2[e] = 0.f; p1[e] = 0.f; }
        } else {
            const u32x4 a = *(const u32x4*)(vv + (size_t)(t0 - 2) * DM + cgp * 8), b = *(const u32x4*)(vv + (size_t)(t0 - 1) * DM + cgp * 8);
#pragma unroll
            for (int e = 0; e < 4; ++e) { p2[2 * e] = bf_lo(a[e]); p2[2 * e + 1] = bf_hi(a[e]); p1[2 * e] = bf_lo(b[e]); p1[2 * e + 1] = bf_hi(b[e]); }
        }
#pragma unroll 1
        for (int tb = t0; tb < t0 + 16; tb += 8) {
            u32x4 cc[8], gq[8];
#pragma unroll
            for (int rr = 0; rr < 8; ++rr) { cc[rr] = *(const u32x4*)(vv + (size_t)(tb + rr) * DM + cgp * 8); gq[rr] = *(const u32x4*)(gb + (size_t)(tb + rr) * DM + cgp * 8); }
            asm volatile("" : "+v"(cc[0]), "+v"(cc[1]), "+v"(cc[2]), "+v"(cc[3]), "+v"(cc[4]), "+v"(cc[5]), "+v"(cc[6]), "+v"(cc[7]),
                              "+v"(gq[0]), "+v"(gq[1]), "+v"(gq[2]), "+v"(gq[3]), "+v"(gq[4]), "+v"(gq[5]), "+v"(gq[6]), "+v"(gq[7]));
#pragma unroll
            for (int rr = 0; rr < 8; ++rr) {
                float cur[8], gv[8], y[8];
#pragma unroll
                for (int e = 0; e < 4; ++e) { cur[2 * e] = bf_lo(cc[rr][e]); cur[2 * e + 1] = bf_hi(cc[rr][e]); gv[2 * e] = bf_lo(gq[rr][e]); gv[2 * e + 1] = bf_hi(gq[rr][e]); }
#pragma unroll
                for (int e = 0; e < 8; ++e) { y[e] = gv[e] * (w0[e] * p2[e] + w1[e] * p1[e] + w2[e] * cur[e]); p2[e] = p1[e]; p1[e] = cur[e]; }
                u32x4 w; w.x = pk_bf16(y[0], y[1]); w.y = pk_bf16(y[2], y[3]); w.z = pk_bf16(y[4], y[5]); w.w = pk_bf16(y[6], y[7]);
                *(u32x4*)(out + (size_t)(tb + rr) * DM + cgp * 8) = w;
            }
        }
    }
}

__device__ __forceinline__ void norm_phase(const float* src, int pitch, bool has_kv, const float* qg, const float* kvg,
                                           bf16_t* cqn, bf16_t* ckv, bf16_t* kpe, const float* cosT, const float* sinT) {
    (void)has_kv;
    int tid = threadIdx.x; asm volatile("" : "+v"(tid));
    const int wid = tid >> 6, lane = tid & 63, l32 = lane & 31;
    const int rstride = (int)gridDim.x * 8;
    const f32x4 gqa = *(const f32x4*)(qg + 8 * lane), gqb = *(const f32x4*)(qg + 8 * lane + 4), gka = *(const f32x4*)(kvg + 8 * lane), gkb = *(const f32x4*)(kvg + 8 * lane + 4);
    for (int base = blockIdx.x * 8 + wid; base < T_TOK; base += 4 * rstride) {
        f32x4 qa[4], qb[4], ka[4], kb[4]; float x1[4], x2[4], cs[4], sn[4];
#pragma unroll
        for (int u = 0; u < 4; ++u) { int row = base + u * rstride; if (row >= T_TOK) row = base; const float* sr = src + (size_t)row * pitch;
            qa[u] = *(const f32x4*)(sr + 8 * lane); qb[u] = *(const f32x4*)(sr + 8 * lane + 4); ka[u] = *(const f32x4*)(sr + 512 + 8 * lane); kb[u] = *(const f32x4*)(sr + 512 + 8 * lane + 4);
            x1[u] = sr[1024 + l32]; x2[u] = sr[1056 + l32]; const int pos = row & (SEQ - 1); cs[u] = cosT[pos * 32 + l32]; sn[u] = sinT[pos * 32 + l32]; }
        asm volatile("" : "+v"(qa[0]), "+v"(qa[1]), "+v"(qa[2]), "+v"(qa[3]), "+v"(qb[0]), "+v"(qb[1]), "+v"(qb[2]), "+v"(qb[3]),
                          "+v"(ka[0]), "+v"(ka[1]), "+v"(ka[2]), "+v"(ka[3]), "+v"(kb[0]), "+v"(kb[1]), "+v"(kb[2]), "+v"(kb[3]));
        float sq[4], sk[4];
#pragma unroll
        for (int u = 0; u < 4; ++u) { const f32x4 a = qa[u], b = qb[u], c = ka[u], d = kb[u];
            sq[u] = (a[0] * a[0] + a[1] * a[1]) + (a[2] * a[2] + a[3] * a[3]) + (b[0] * b[0] + b[1] * b[1]) + (b[2] * b[2] + b[3] * b[3]);
            sk[u] = (c[0] * c[0] + c[1] * c[1]) + (c[2] * c[2] + c[3] * c[3]) + (d[0] * d[0] + d[1] * d[1]) + (d[2] * d[2] + d[3] * d[3]); }
#pragma unroll
        for (int o = 32; o >= 1; o >>= 1) {
#pragma unroll
            for (int u = 0; u < 4; ++u) { sq[u] += __shfl_xor(sq[u], o); sk[u] += __shfl_xor(sk[u], o); } }
#pragma unroll
        for (int u = 0; u < 4; ++u) { const int row = base + u * rstride; if (row < T_TOK) {
            const float rq = rsqrtf(sq[u] * (1.0f / 512.0f) + RMS_EPS), rk = rsqrtf(sk[u] * (1.0f / 512.0f) + RMS_EPS);
            const f32x4 ya = qa[u] * rq * gqa, yb = qb[u] * rq * gqb, za = ka[u] * rk * gka, zb = kb[u] * rk * gkb;
            u32x4 w; w.x = pk_bf16(ya[0], ya[1]); w.y = pk_bf16(ya[2], ya[3]); w.z = pk_bf16(yb[0], yb[1]); w.w = pk_bf16(yb[2], yb[3]);
            *(u32x4*)(cqn + (size_t)row * 512 + 8 * lane) = w;
            u32x4 w2; w2.x = pk_bf16(za[0], za[1]); w2.y = pk_bf16(za[2], za[3]); w2.z = pk_bf16(zb[0], zb[1]); w2.w = pk_bf16(zb[2], zb[3]);
            *(u32x4*)(ckv + (size_t)row * 512 + 8 * lane) = w2;
            if (lane < 32) {
                const float o1 = x1[u] * cs[u] - x2[u] * sn[u], o2 = x2[u] * cs[u] + x1[u] * sn[u];
                const int pp = 8 * (lane >> 2) + (lane & 3);
                kpe[(size_t)row * 64 + pp] = (bf16_t)(pk_bf16(o1, 0.f) & 0xffffu);
                kpe[(size_t)row * 64 + pp + 4] = (bf16_t)(pk_bf16(o2, 0.f) & 0xffffu);
            } } }
    }
}

__device__ __forceinline__ void norm_phase_split(const bf16_t* part, const float* qg, bf16_t* cqn) {
    int tid = threadIdx.x; asm volatile("" : "+v"(tid));
    const int wid = tid >> 6, lane = tid & 63;
    const int rstride = (int)gridDim.x * 8;
    const f32x4 ga = *(const f32x4*)(qg + 8 * lane), gb2 = *(const f32x4*)(qg + 8 * lane + 4);
    for (int base = blockIdx.x * 8 + wid; base < T_TOK; base += 4 * rstride) {
        u32x4 pw[4][4];
#pragma unroll
        for (int u = 0; u < 4; ++u) { int row = base + u * rstride; if (row >= T_TOK) row = base; const bf16_t* sr = part + (size_t)row * 2048 + 8 * lane;
#pragma unroll
            for (int sp = 0; sp < 4; ++sp) pw[u][sp] = *(const u32x4*)(sr + sp * 512); }
        asm volatile("" : "+v"(pw[0][0]), "+v"(pw[0][1]), "+v"(pw[0][2]), "+v"(pw[0][3]), "+v"(pw[1][0]), "+v"(pw[1][1]), "+v"(pw[1][2]), "+v"(pw[1][3]),
                          "+v"(pw[2][0]), "+v"(pw[2][1]), "+v"(pw[2][2]), "+v"(pw[2][3]), "+v"(pw[3][0]), "+v"(pw[3][1]), "+v"(pw[3][2]), "+v"(pw[3][3]));
        float x[4][8], ss[4];
#pragma unroll
        for (int u = 0; u < 4; ++u) {
#pragma unroll
            for (int e = 0; e < 8; ++e) x[u][e] = 0.f;
#pragma unroll
            for (int sp = 0; sp < 4; ++sp)
#pragma unroll
                for (int e = 0; e < 4; ++e) { x[u][2 * e] += bf_lo(pw[u][sp][e]); x[u][2 * e + 1] += bf_hi(pw[u][sp][e]); }
            ss[u] = 0.f;
#pragma unroll
            for (int e = 0; e < 8; ++e) ss[u] += x[u][e] * x[u][e]; }
#pragma unroll
        for (int o = 32; o >= 1; o >>= 1) {
#pragma unroll
            for (int u = 0; u < 4; ++u) ss[u] += __shfl_xor(ss[u], o); }
#pragma unroll
        for (int u = 0; u < 4; ++u) { const int row = base + u * rstride; if (row < T_TOK) {
            const float rr = rsqrtf(ss[u] * (1.0f / 512.0f) + RMS_EPS);
            u32x4 w; w.x = pk_bf16(x[u][0] * rr * ga[0], x[u][1] * rr * ga[1]); w.y = pk_bf16(x[u][2] * rr * ga[2], x[u][3] * rr * ga[3]);
            w.z = pk_bf16(x[u][4] * rr * gb2[0], x[u][5] * rr * gb2[1]); w.w = pk_bf16(x[u][6] * rr * gb2[2], x[u][7] * rr * gb2[3]);
            *(u32x4*)(cqn + (size_t)row * 512 + 8 * lane) = w; } }
    }
}

constexpr int KROWB = 400, VROWB = 136, KBUF = 64 * KROWB, ABUF = KBUF + 128 * VROWB;
__device__ __forceinline__ void attn_block(LAS unsigned char* lds, const bf16_t* q, const bf16_t* kn, const bf16_t* kpe, const bf16_t* vt,
                                           bf16_t* o, int b, int h, int qb) {
    int tid = threadIdx.x; asm volatile("" : "+v"(tid));
    const int wid = __builtin_amdgcn_readfirstlane(tid >> 6), lane = tid & 63, r = lane & 31, hh = lane >> 5;
    const int q0 = qb * 256, qw0 = q0 + wid * 32;
    const int nt = (q0 + 256) >> 6;
    const size_t tokb = (size_t)b * SEQ;
    bf16x8 qf[12];
    { const bf16_t* qrow = q + (tokb + qw0 + r) * 3072;
#pragma unroll
      for (int ks = 0; ks < 8; ++ks) qf[ks] = *(const bf16x8*)(qrow + h * 128 + ks * 16 + hh * 8);
#pragma unroll
      for (int ks = 8; ks < 12; ++ks) qf[ks] = *(const bf16x8*)(qrow + 2048 + h * 64 + (ks - 8) * 16 + hh * 8); }
    f32x16 oacc[4];
#pragma unroll
    for (int d = 0; d < 4; ++d)
#pragma unroll
        for (int i = 0; i < 16; ++i) oacc[d][i] = 0.f;
    float mrun = -1e30f, lrun = 0.f;
    const bf16_t* knb = kn + tokb * DM + h * 128; const bf16_t* peb = kpe + tokb * 64; const bf16_t* vtb = vt + (size_t)h * 128 * T_TOK + tokb;
    const unsigned koff = (unsigned)((tid >> 4) * DM + (tid & 15) * 8), kdst = (unsigned)((tid >> 4) * KROWB + (tid & 15) * 16);
    const unsigned peoff = (unsigned)((tid >> 3) * 64 + (tid & 7) * 8), pedst = (unsigned)((tid >> 3) * KROWB + 256 + (tid & 7) * 16);
    const unsigned voff = (unsigned)((tid >> 3) * T_TOK + (tid & 7) * 8), vdst = (unsigned)(KBUF + (tid >> 3) * VROWB + (tid & 7) * 16);
    u32x4 kr[3], vr[2];
#define ATT_LOAD(t) do { const bf16_t* kt_ = knb + (size_t)(t) * 64 * DM; kr[0] = *(const u32x4*)(kt_ + koff); kr[1] = *(const u32x4*)(kt_ + koff + 32 * DM); \
        kr[2] = *(const u32x4*)(peb + (size_t)(t) * 64 * 64 + peoff); const bf16_t* vt_ = vtb + (size_t)(t) * 64; vr[0] = *(const u32x4*)(vt_ + voff); vr[1] = *(const u32x4*)(vt_ + voff + 64 * T_TOK); } while (0)
#define ATT_WRITE(bf_) do { LAS unsigned char* b_ = lds + (bf_) * ABUF; *(LAS u32x4*)(b_ + kdst) = kr[0]; *(LAS u32x4*)(b_ + kdst + 32 * KROWB) = kr[1]; *(LAS u32x4*)(b_ + pedst) = kr[2]; \
        _Pragma("unroll") for (int i = 0; i < 2; ++i) { *(LAS u32x2*)(b_ + vdst + i * 64 * VROWB) = (u32x2){vr[i].x, vr[i].y}; *(LAS u32x2*)(b_ + vdst + i * 64 * VROWB + 8) = (u32x2){vr[i].z, vr[i].w}; } } while (0)
    ATT_LOAD(0); ATT_WRITE(0);
    __builtin_amdgcn_s_waitcnt(0x0F70);
    __syncthreads();
    const int qrow = qw0 + r;
    for (int t = 0; t < nt; ++t) {
        const int buf = t & 1, kbase = t * 64;
        if (t + 1 < nt) ATT_LOAD(t + 1);
        if (kbase <= qw0 + 31) {
            LAS unsigned char* kb = lds + buf * ABUF; LAS unsigned char* vb = kb + KBUF;
            f32x16 s0, s1;
#pragma unroll
            for (int i = 0; i < 16; ++i) { s0[i] = 0.f; s1[i] = 0.f; }
            bf16x8 kf[3][4];
#define ATT_LDK(bufi, g) do { _Pragma("unroll") for (int ksl = 0; ksl < 2; ++ksl) { \
                kf[bufi][2 * ksl] = *(const LAS bf16x8*)(kb + r * KROWB + (((g) * 2 + ksl) * 16 + hh * 8) * 2); \
                kf[bufi][2 * ksl + 1] = *(const LAS bf16x8*)(kb + (32 + r) * KROWB + (((g) * 2 + ksl) * 16 + hh * 8) * 2); } } while (0)
            ATT_LDK(0, 0); ATT_LDK(1, 1);
            __builtin_amdgcn_sched_barrier(0);
#pragma unroll
            for (int g = 0; g < 6; ++g) {
                if (g + 2 < 6) ATT_LDK((g + 2) % 3, g + 2);
#pragma unroll
                for (int ksl = 0; ksl < 2; ++ksl) {
                    s0 = __builtin_amdgcn_mfma_f32_32x32x16_bf16(kf[g % 3][2 * ksl], qf[g * 2 + ksl], s0, 0, 0, 0);
                    s1 = __builtin_amdgcn_mfma_f32_32x32x16_bf16(kf[g % 3][2 * ksl + 1], qf[g * 2 + ksl], s1, 0, 0, 0);
                }
                __builtin_amdgcn_sched_barrier(0);
            }
#undef ATT_LDK
            if (kbase + 63 > qw0) {
                asm volatile("" ::: "memory");
#pragma unroll
                for (int i = 0; i < 16; ++i) { const int key = kbase + (i >> 2) * 8 + hh * 4 + (i & 3);
                    if (key > qrow) s0[i] = -INFINITY; if (key + 32 > qrow) s1[i] = -INFINITY; }
            }
            float mx = s0[0];
#pragma unroll
            for (int i = 1; i < 16; ++i) mx = fmaxf(mx, s0[i]);
#pragma unroll
            for (int i = 0; i < 16; ++i) mx = fmaxf(mx, s1[i]);
            mx = fmaxf(mx, __shfl_xor(mx, 32));
            if (__builtin_amdgcn_ballot_w64(mx > mrun + 8.0f) != 0ull) {
                asm volatile("" ::: "memory");
                const float mnew = fmaxf(mrun, mx);
                const float alpha = __builtin_amdgcn_exp2f(mrun - mnew);
                lrun *= alpha; mrun = mnew;
#pragma unroll
                for (int d = 0; d < 4; ++d)
#pragma unroll
                    for (int i = 0; i < 16; ++i) oacc[d][i] *= alpha;
            }
            float rs = 0.f;
#pragma unroll
            for (int i = 0; i < 16; ++i) { s0[i] = __builtin_amdgcn_exp2f(s0[i] - mrun); s1[i] = __builtin_amdgcn_exp2f(s1[i] - mrun); rs += s0[i] + s1[i]; }
            lrun += rs;
            bf16x8 vfr[2][4];
#define ATT_LDV(bufi, j) do { _Pragma("unroll") for (int d = 0; d < 4; ++d) { \
                const LAS unsigned char* vp = vb + (d * 32 + r) * VROWB + ((j) * 16 + hh * 4) * 2; \
                const u32x2 lo = *(const LAS u32x2*)vp, hi = *(const LAS u32x2*)(vp + 16); \
                vfr[bufi][d] = __builtin_bit_cast(bf16x8, (u32x4){lo.x, lo.y, hi.x, hi.y}); } } while (0)
            ATT_LDV(0, 0);
            __builtin_amdgcn_sched_barrier(0);
#pragma unroll
            for (int j = 0; j < 4; ++j) {
                if (j + 1 < 4) ATT_LDV((j + 1) & 1, j + 1);
                u32x4 pw;
                if (j == 0) { pw.x = pk_bf16(s0[0], s0[1]); pw.y = pk_bf16(s0[2], s0[3]); pw.z = pk_bf16(s0[4], s0[5]); pw.w = pk_bf16(s0[6], s0[7]); }
                else if (j == 1) { pw.x = pk_bf16(s0[8], s0[9]); pw.y = pk_bf16(s0[10], s0[11]); pw.z = pk_bf16(s0[12], s0[13]); pw.w = pk_bf16(s0[14], s0[15]); }
                else if (j == 2) { pw.x = pk_bf16(s1[0], s1[1]); pw.y = pk_bf16(s1[2], s1[3]); pw.z = pk_bf16(s1[4], s1[5]); pw.w = pk_bf16(s1[6], s1[7]); }
                else { pw.x = pk_bf16(s1[8], s1[9]); pw.y = pk_bf16(s1[10], s1[11]); pw.z = pk_bf16(s1[12], s1[13]); pw.w = pk_bf16(s1[14], s1[15]); }
                const bf16x8 pf = __builtin_bit_cast(bf16x8, pw);
#pragma unroll
                for (int d = 0; d < 4; ++d) oacc[d] = __builtin_amdgcn_mfma_f32_32x32x16_bf16(vfr[j & 1][d], pf, oacc[d], 0, 0, 0);
                __builtin_amdgcn_sched_barrier(0);
            }
#undef ATT_LDV
        }
        if (t + 1 < nt) ATT_WRITE(buf ^ 1);
        __syncthreads();
    }
#undef ATT_LOAD
#undef ATT_WRITE
    lrun += __shfl_xor(lrun, 32);
    const float inv = 1.0f / lrun;
    bf16_t* orow = o + (tokb + qrow) * DM + h * 128;
#pragma unroll
    for (int d = 0; d < 4; ++d)
#pragma unroll
        for (int g4 = 0; g4 < 4; ++g4) { u32x2 w; w.x = pk_bf16(oacc[d][4 * g4] * inv, oacc[d][4 * g4 + 1] * inv); w.y = pk_bf16(oacc[d][4 * g4 + 2] * inv, oacc[d][4 * g4 + 3] * inv);
            *(u32x2*)(orow + d * 32 + g4 * 8 + hh * 4) = w; }
}

__device__ __forceinline__ void attn_phase(LAS unsigned char* lds, const bf16_t* q, const bf16_t* kn, const bf16_t* kpe, const bf16_t* vt, bf16_t* o) {
    for (int pi = blockIdx.x; pi < 256; pi += gridDim.x) {
        const int bh = ((pi >> 5) << 3) | (pi & 7), x = (pi >> 3) & 3, b = bh >> 4, h = bh & 15;
        attn_block(lds, q, kn, kpe, vt, o, b, h, 7 - x);
        attn_block(lds, q, kn, kpe, vt, o, b, h, x);
    }
}

__global__ void __launch_bounds__(512, 2) yoco_megakernel(Params p) {
    extern __shared__ __attribute__((aligned(16))) unsigned char shm[];
    LAS unsigned char* lds = (LAS unsigned char*)shm;
    cg::grid_group grid = cg::this_grid();
    if (p.cg_flag) grid.sync();
    volatile LAS unsigned* xst = (volatile LAS unsigned*)(lds + 131072);
    if (threadIdx.x == 0) { xst[0] = 0u; xst[1] = 0u; xst[2] = 0u; xst[3] = 0u; }
    __syncthreads();
    const XcdBarrier xb = xcd_barrier_post(p.bar, xst);
#define GSYNC() xcd_barrier(xb)

    if constexpr (PH_MASK & 1) convert_phase(p, lds);
    if constexpr (DUP_MASK & 1) { __syncthreads(); convert_phase(p, lds); }
    GSYNC();

    const float* res = p.x;
#pragma unroll 1
    for (int layer = 0; layer < 4; ++layer) {
        const float* g0 = p.ln_g + (size_t)(layer * 2) * DM; const float* b0 = p.ln_b + (size_t)(layer * 2) * DM;
        const float* g1 = g0 + DM; const float* b1 = b0 + DM;
        const bf16_t* mixA; const bf16_t* mixW;
        if (layer < 2) {
            run_gemm<T_TOK, 6144, DM>(lds, p.hb, p.win + (size_t)layer * 6144 * DM, EpiWin{p.gb, p.vv});
            GSYNC();
            if constexpr (DUP_MASK & 32) conv_phase(p.gb, p.vv, p.conv_w + (size_t)layer * 3 * DM, p.gg);
            if constexpr (PH_MASK & 4) conv_phase(p.gb, p.vv, p.conv_w + (size_t)layer * 3 * DM, p.gg);
            GSYNC();
            mixA = p.gg; mixW = p.wout + (size_t)layer * DM * DM;
        } else {
            const int j = layer - 2;
            if (j == 0) {
                run_gemm<T_TOK, 1280, DM>(lds, p.hb, p.wdqkv, EpiF32<1280>{p.cqkv});
                GSYNC();
                if constexpr (PH_MASK & 32) norm_phase(p.cqkv, 1280, true, p.q_norm_g, p.kv_norm_g, p.cqn, p.ckv, p.kpe, p.cosT, p.sinT);
                GSYNC();
                run_gemm<T_TOK, DM, 512>(lds, p.ckv, p.wk, EpiBf16<DM>{p.kn});
                run_gemm<DM, T_TOK, 512>(lds, p.wv, p.ckv, EpiBf16<T_TOK>{p.vt});
            } else {
                {
                  pg8::Gemm g{p.hb, p.wdq3, T_TOK, 2048, 512}; pg8::StaticOrder S; S.init(T_TOK, 2048, (int)gridDim.x, (int)blockIdx.x);
                  pg8::gemm_phase<EpiBf16<2048>, 512, DM, 2>(lds, g, S, EpiBf16<2048>{(bf16_t*)p.cqkv}); }
                GSYNC();
                norm_phase_split((const bf16_t*)p.cqkv, p.q_norm_g + 512, p.cqn);
                GSYNC();
            }
            run_gemm<T_TOK, 3072, 512>(lds, p.cqn, p.wuq + (size_t)j * 3072 * 512, EpiQ{p.qb, p.cosT, p.sinT});
            GSYNC();
            if constexpr (PH_MASK & 2) attn_phase(lds, p.qb, p.kn, p.kpe, p.vt, p.ob);
            if constexpr (DUP_MASK & 2) { for (int rep = 0; rep < 2; ++rep) { __syncthreads(); attn_phase(lds, p.qb, p.kn, p.kpe, p.vt, p.ob); } }
            GSYNC();
            mixA = p.ob; mixW = p.wo + (size_t)j * DM * DM;
        }
        run_gemm<T_TOK, DM, DM>(lds, mixA, mixW, EpiZLn{p.hb, g0, b0, (float*)nullptr, p.hb, p.xbuf + (size_t)(layer * 2) * T_TOK * 8, p.lncnt + (layer * 2) * 32 * 64});
        GSYNC();
        run_gemm<T_TOK, DFF, DM>(lds, p.hb, p.w1 + (size_t)layer * DFF * DM, EpiRelu2{p.a1});
        GSYNC();
        run_gemm<T_TOK, DM, DFF>(lds, p.a1, p.w2 + (size_t)layer * DM * DFF, EpiZLn{p.hb, g1, b1, layer < 3 ? (float*)nullptr : p.out, p.hb, p.xbuf + (size_t)(layer * 2 + 1) * T_TOK * 8, p.lncnt + (layer * 2 + 1) * 32 * 64});
        GSYNC();
        res = p.ha;
        if constexpr (DUP_MASK & 16) { GSYNC(); GSYNC(); GSYNC(); GSYNC(); GSYNC(); }
    }
}

extern "C" void kernel_launch(void* const* d_in, const int* in_sizes, int n_in, void* d_out, int out_size, void* d_ws, size_t ws_size, hipStream_t stream) {
    (void)in_sizes; (void)n_in; (void)out_size; (void)ws_size;
    static int grid_blocks = 0;
    if (!grid_blocks) {
        hipFuncSetAttribute((const void*)yoco_megakernel, hipFuncAttributeMaxDynamicSharedMemorySize, DYN_LDS);
        int dev = 0, cus = 0, per_cu = 0;
        hipGetDevice(&dev);
        hipDeviceGetAttribute(&cus, hipDeviceAttributeMultiprocessorCount, dev);
        hipOccupancyMaxActiveBlocksPerMultiprocessor(&per_cu, yoco_megakernel, 512, DYN_LDS);
        if (per_cu < 1) per_cu = 1;
        if (per_cu > 1) per_cu = 1;
        grid_blocks = 256;
        (void)cus;
    }
    const float* x = (const float*)d_in[0];
    const float* ln_g = (const float*)d_in[1];
    const float* ln_b = (const float*)d_in[2];
    const float* conv_w_in = (const float*)d_in[3];
    const float* conv_w = (const float*)d_in[4];
    const float* conv_w_out = (const float*)d_in[5];
    const float* kv_w_dkv = (const float*)d_in[6];
    const float* kv_norm_g = (const float*)d_in[7];
    const float* kv_w_ukv = (const float*)d_in[8];
    const float* mla_w_dq = (const float*)d_in[9];
    const float* mla_q_norm_g = (const float*)d_in[10];
    const float* mla_w_uq = (const float*)d_in[11];
    const float* mla_w_o = (const float*)d_in[12];
    const float* mlp_w1 = (const float*)d_in[13];
    const float* mlp_w2 = (const float*)d_in[14];

    Params p;
    memset(&p, 0, sizeof(p));
    p.x = x; p.ln_g = ln_g; p.ln_b = ln_b; p.conv_w = conv_w; p.kv_norm_g = kv_norm_g; p.q_norm_g = mla_q_norm_g; p.out = (float*)d_out;
    size_t off = 0;
    auto alloc = [&](size_t bytes) { void* r = (char*)d_ws + off; off += (bytes + 255) & ~(size_t)255; return r; };
    p.win = (bf16_t*)alloc((size_t)2 * 6144 * DM * 2);
    p.wout = (bf16_t*)alloc((size_t)2 * DM * DM * 2);
    p.wdqkv = (bf16_t*)alloc((size_t)1280 * DM * 2);
    p.wdq3 = (bf16_t*)alloc((size_t)512 * DM * 2);
    p.wk = (bf16_t*)alloc((size_t)DM * 512 * 2);
    p.wv = (bf16_t*)alloc((size_t)DM * 512 * 2);
    p.wuq = (bf16_t*)alloc((size_t)2 * 3072 * 512 * 2);
    p.wo = (bf16_t*)alloc((size_t)2 * DM * DM * 2);
    p.w1 = (bf16_t*)alloc((size_t)4 * DFF * DM * 2);
    p.w2 = (bf16_t*)alloc((size_t)4 * DM * DFF * 2);
    p.hb = (bf16_t*)alloc((size_t)T_TOK * DM * 2);
    p.ha = (float*)alloc((size_t)T_TOK * DM * 4);
    p.z = (float*)alloc((size_t)T_TOK * DM * 4);
    p.a1 = (bf16_t*)alloc((size_t)T_TOK * DFF * 2);
    p.gb = p.a1; p.vv = p.a1 + (size_t)T_TOK * DM; p.gg = p.a1 + (size_t)2 * T_TOK * DM;
    p.qb = p.a1; p.ob = p.a1 + (size_t)T_TOK * 3072;
    p.cqkv = (float*)alloc((size_t)T_TOK * 1280 * 4);
    p.cqn = (bf16_t*)alloc((size_t)T_TOK * 512 * 2);
    p.ckv = (bf16_t*)alloc((size_t)T_TOK * 512 * 2);
    p.kpe = (bf16_t*)alloc((size_t)T_TOK * 64 * 2);
    p.kn = (bf16_t*)alloc((size_t)T_TOK * DM * 2);
    p.vt = (bf16_t*)alloc((size_t)DM * T_TOK * 2);
    p.bar = (unsigned*)alloc((size_t)XCD_BAR_WORDS * 4);
    p.lncnt = (unsigned*)alloc((size_t)8 * 32 * 64 * 4);
    p.xbuf = (unsigned long long*)alloc((size_t)8 * T_TOK * 8 * 8);
    p.cosT = (float*)alloc((size_t)SEQ * 32 * 4);
    p.sinT = (float*)alloc((size_t)SEQ * 32 * 4);

    int nj = 0, tcount = 0;
    auto job = [&](const float* src, bf16_t* dst, int K, int pitch, int nrows, int type) { p.jobs[nj].src = src; p.jobs[nj].dst = dst; p.jobs[nj].K = K; p.jobs[nj].pitch = pitch; p.jobs[nj].ntn = nrows / 64; p.jobs[nj].type = type; p.jobs[nj].tstart = tcount; tcount += (nrows / 64) * (K / 256); ++nj; };
    for (int l = 0; l < 4; ++l) job(mlp_w1 + (size_t)l * DM * DFF, p.w1 + (size_t)l * DFF * DM, DM, DFF, DFF, 0);
    for (int l = 0; l < 4; ++l) job(mlp_w2 + (size_t)l * DFF * DM, p.w2 + (size_t)l * DM * DFF, DFF, DM, DM, 0);
    for (int l = 0; l < 2; ++l) job(conv_w_in + (size_t)l * DM * 6144, p.win + (size_t)l * 6144 * DM, DM, 6144, 6144, 1);
    for (int l = 0; l < 2; ++l) job(conv_w_out + (size_t)l * DM * DM, p.wout + (size_t)l * DM * DM, DM, DM, DM, 0);
    for (int l = 0; l < 2; ++l) job(mla_w_o + (size_t)l * DM * DM, p.wo + (size_t)l * DM * DM, DM, DM, DM, 0);
    for (int l = 0; l < 2; ++l) job(mla_w_uq + (size_t)l * 512 * 3072, p.wuq + (size_t)l * 3072 * 512, 512, 3072, 3072, 2);
    job(mla_w_dq, p.wdqkv, DM, 512, 512, 0);
    job(kv_w_dkv, p.wdqkv + (size_t)512 * DM, DM, 576, 576, 0);
    for (int sp = 0; sp < 4; ++sp) job(mla_w_dq + (size_t)DM * 512 + (size_t)sp * 512 * 512, p.wdq3 + (size_t)sp * 512 * 512, 512, 512, 512, 0);
    job(kv_w_ukv, p.wk, 512, 4096, DM, 3);
    job(kv_w_ukv, p.wv, 512, 4096, DM, 4);

    (void)hipMemsetAsync(p.bar, 0, (size_t)((char*)p.xbuf - (char*)p.bar), stream);
    void* args[] = {&p};
    hipError_t e = hipLaunchCooperativeKernel((const void*)yoco_megakernel, dim3(grid_blocks), dim3(512), args, DYN_LDS, stream);
    if (e != hipSuccess) fprintf(stderr, "cooperative launch failed: %s (grid %d)\n", hipGetErrorString(e), grid_blocks);
}
```

```cpp
#include <hip/hip_runtime.h>
#include <hip/hip_cooperative_groups.h>
#include <cstdio>
#include <cstring>
namespace cg = cooperative_groups;

#define LAS __attribute__((address_space(3)))
typedef unsigned short bf16_t;
typedef short bf16x8 __attribute__((ext_vector_type(8)));
typedef float f32x2 __attribute__((ext_vector_type(2)));
typedef float f32x4 __attribute__((ext_vector_type(4)));
typedef float f32x16 __attribute__((ext_vector_type(16)));
typedef unsigned u32x4 __attribute__((ext_vector_type(4)));
typedef unsigned u32x2 __attribute__((ext_vector_type(2)));
typedef __bf16 bf16v2 __attribute__((ext_vector_type(2)));

constexpr int T_TOK = 8192, DM = 2048, DFF = 8192, SEQ = 2048;
constexpr float ALPHA = 1.6817928305074290f;
constexpr float LN_EPS = 1e-5f, RMS_EPS = 1e-6f;
constexpr float QSCALE = 0.07216878364870323f * 1.4426950408889634f;
constexpr int NJOBS = 24;
constexpr int DYN_LDS = 131072 + 16;
#ifndef PH_MASK
#define PH_MASK 0xff
#endif
#ifndef DUP_MASK
#define DUP_MASK 0
#endif
#ifndef DUP_EPI
#define DUP_EPI 0xff
#endif
#ifndef EPI_MASK
#define EPI_MASK 0xff
#endif

__device__ __forceinline__ unsigned pk_bf16(float lo, float hi) {
    bf16v2 v = __builtin_convertvector((f32x2){lo, hi}, bf16v2);
    return __builtin_bit_cast(unsigned, v);
}
__device__ __forceinline__ float bf_lo(unsigned w) { return __uint_as_float(w << 16); }
__device__ __forceinline__ float bf_hi(unsigned w) { return __uint_as_float(w & 0xffff0000u); }

namespace pg8 {
constexpr int BM = 256, BK = 64, HALF = 128, HTB = HALF * BK * 2, STAGE_BYTES = 8 * HTB, NXCD = 8, WGM = 8;
__host__ __device__ __forceinline__ int lds_byte(int r, int c) { const int st = (r >> 4) * 2 + (c >> 5), rr = r & 15, cc = c & 31, ob = rr * 64 + cc * 2; return st * 1024 + (ob ^ (((ob >> 9) & 1) << 5)); }
__host__ __device__ __forceinline__ void stage_rc(int b, int& R, int& C) { const int st = b / 1024, sb = b % 1024, swz = sb ^ (((sb >> 9) & 1) << 5); R = (st >> 1) * 16 + swz / 64; C = (st & 1) * 32 + (swz % 64) / 2; }
__host__ __device__ __forceinline__ int perm32(int rho) { const int n = rho >> 4, i = rho & 15; return 8 * (i >> 2) + 4 * n + (i & 3); }

struct Unit { int pm, pn; };
struct Gemm { const bf16_t* A; const bf16_t* Bt; int M, N, K; };
struct StaticOrder {
    int nM, nN, nwg, G, c;
    __device__ void init(int M, int N, int G_, int c_) { nM = M / BM; nN = N / BM; nwg = nM * nN; G = G_; c = c_; }
    __device__ bool next(int i, Unit& u) const {
        const long L = (long)i * G + c; if (L >= nwg) return false;
        int wgid = (int)L; { const int q = nwg / NXCD, r = nwg % NXCD, xcd = wgid % NXCD, off = wgid / NXCD; wgid = (xcd < r ? xcd * (q + 1) : r * (q + 1) + (xcd - r) * q) + off; }
        const int nig = WGM * nN, gid = wgid / nig, fm = gid * WGM, gsz = (nM - fm) < WGM ? (nM - fm) : WGM;
        u.pm = fm + ((wgid % nig) % gsz); u.pn = (wgid % nig) / gsz; return true;
    }
};

template <class Epi, int K, int LDA = K, int ASPLIT = 0, int ATILE = 0>
__device__ __forceinline__ void gemm_phase(LAS unsigned char* lds, const Gemm g, const StaticOrder& S, const Epi& E) {
    int tid = threadIdx.x; asm volatile("" : "+v"(tid));
    const int wid = __builtin_amdgcn_readfirstlane(tid >> 6), lane = tid & 63, wr = wid >> 2, wc = wid & 3, fr = lane & 15, fq = lane >> 4;
    constexpr int nt = K / BK;
    unsigned voffA[2], voffB[2];
#pragma unroll
    for (int i = 0; i < 2; ++i) { int R, C; stage_rc(tid * 16 + i * 8192, R, C); const int Rb = Epi::PERM ? ((R & ~31) + perm32(R & 31)) : R;
        voffA[i] = (unsigned)(R * LDA + C) * 2u; voffB[i] = (unsigned)(Rb * K + C) * 2u; }
    const size_t kstep = (size_t)(BK * 2);
    const size_t hstep = (size_t)HALF * K * 2;
    const size_t tstep = 2 * hstep;
    const size_t hstepA = (size_t)HALF * LDA * 2;
    const size_t tstepA = 2 * hstepA;
#define PG8_AOFF(u) (ATILE ? (size_t)(u).pm * ((size_t)(K / 256) * 131072) : ((size_t)(u).pm * tstepA + (ASPLIT ? (size_t)((u).pn / (ASPLIT ? ASPLIT : 1)) * K * 2 : (size_t)0)))
#define PG8_AK(base, t_) ((base) + (ATILE ? (unsigned)((((t_) >> 2) << 17) | (((t_) & 3) << 7)) : (unsigned)((t_) * (BK * 2))))
    const unsigned ldsw = (unsigned)wid * 1024u;
    const int aoff = lds_byte(wr * 64 + fr, fq * 8), boff = lds_byte(wc * 32 + fr, fq * 8);
#define PG8_SA(b, h) (((b) * 2 + (h)) * HTB)
#define PG8_SB(b, h) ((4 + (b) * 2 + (h)) * HTB)
#define PG8_STAGE(bufoff, gbase, voff) do { _Pragma("unroll") for (int _i = 0; _i < 2; ++_i) \
        __builtin_amdgcn_global_load_lds((const unsigned*)((const char*)(gbase) + (voff)[_i]), (LAS unsigned*)(lds + (bufoff) + ldsw + _i * 8192), 16, 0, 0); } while (0)
#define PG8_LDA(dst, b, h) do { _Pragma("unroll") for (int m = 0; m < 4; ++m) _Pragma("unroll") for (int k = 0; k < 2; ++k) dst[m][k] = *(const LAS bf16x8*)(lds + PG8_SA(b, h) + aoff + m * 2048 + k * 1024); } while (0)
#define PG8_LDB(dst, b, h) do { _Pragma("unroll") for (int n = 0; n < 2; ++n) _Pragma("unroll") for (int k = 0; k < 2; ++k) dst[n][k] = *(const LAS bf16x8*)(lds + PG8_SB(b, h) + boff + n * 2048 + k * 1024); } while (0)
#define PG8_MMA(ai, bj, At, Bt) do { __builtin_amdgcn_s_setprio(1); _Pragma("unroll") for (int m = 0; m < 4; ++m) _Pragma("unroll") for (int n = 0; n < 2; ++n) _Pragma("unroll") for (int k = 0; k < 2; ++k) \
        acc[ai][bj][m][n] = __builtin_amdgcn_mfma_f32_16x16x32_bf16(Bt[n][k], At[m][k], acc[ai][bj][m][n], 0, 0, 0); __builtin_amdgcn_s_setprio(0); } while (0)
#define PG8_WAIT_V(n) asm volatile("s_waitcnt vmcnt(" #n ")" ::: "memory")
#define PG8_WAIT_L(n) asm volatile("s_waitcnt lgkmcnt(" #n ")" ::: "memory")
#define PG8_BAR __builtin_amdgcn_s_barrier()
#define PG8_SCHED __builtin_amdgcn_sched_barrier(0)
    Unit cur, nxt; int ui = 0;
    if (!S.next(0, cur)) return;
    f32x4 acc[2][2][4][2];
#pragma unroll
    for (int a = 0; a < 2; ++a)
#pragma unroll
        for (int b = 0; b < 2; ++b)
#pragma unroll
            for (int m = 0; m < 4; ++m)
#pragma unroll
                for (int n = 0; n < 2; ++n) acc[a][b][m][n] = (f32x4){0.f, 0.f, 0.f, 0.f};
    bf16x8 At[4][2], B0[2][2], B1[2][2];
    const char* cA = (const char*)g.A + PG8_AOFF(cur); const char* cB = (const char*)g.Bt + (size_t)cur.pn * tstep;
    PG8_STAGE(PG8_SB(0, 0), cB, voffB); PG8_STAGE(PG8_SA(0, 0), cA, voffA); PG8_STAGE(PG8_SB(0, 1), cB + hstep, voffB); PG8_STAGE(PG8_SA(0, 1), cA + hstepA, voffA);
    if (wr == 1) PG8_BAR;
    PG8_WAIT_V(4); PG8_BAR;
    PG8_STAGE(PG8_SB(1, 0), cB + kstep, voffB); PG8_STAGE(PG8_SA(1, 0), cA + kstep, voffA); PG8_STAGE(PG8_SB(1, 1), cB + hstep + kstep, voffB);
    PG8_WAIT_V(6); PG8_BAR;
    for (;;) {
        const bool has_next = S.next(ui + 1, nxt);
        const char* nA = has_next ? (const char*)g.A + PG8_AOFF(nxt) : cA; const char* nB = has_next ? (const char*)g.Bt + (size_t)nxt.pn * tstep : cB;
        for (int t = 0; t < nt; t += 2) {
            const bool last = (t == nt - 2);
            const char* a1 = PG8_AK(cA, t + 1);
            const char* a2 = last ? nA : PG8_AK(cA, t + 2); const char* b2 = last ? nB : cB + (size_t)(t + 2) * kstep;
            const char* a3 = a2 + kstep; const char* b3 = b2 + kstep;
            PG8_LDB(B0, 0, 0); PG8_SCHED; PG8_LDA(At, 0, 0); PG8_STAGE(PG8_SA(1, 1), a1 + hstepA, voffA);
            PG8_WAIT_L(8); PG8_BAR; PG8_WAIT_L(0); PG8_MMA(0, 0, At, B0); PG8_BAR; PG8_SCHED;
            PG8_LDB(B1, 0, 1); PG8_STAGE(PG8_SB(0, 0), b2, voffB);
            PG8_BAR; PG8_WAIT_L(0); PG8_MMA(0, 1, At, B1); PG8_BAR;
            PG8_LDA(At, 0, 1); PG8_STAGE(PG8_SA(0, 0), a2, voffA);
            PG8_BAR; PG8_WAIT_L(0); PG8_MMA(1, 0, At, B0); PG8_BAR; PG8_SCHED;
            PG8_STAGE(PG8_SB(0, 1), b2 + hstep, voffB);
            PG8_WAIT_V(6); PG8_BAR; PG8_MMA(1, 1, At, B1); PG8_BAR;
            PG8_LDB(B0, 1, 0); PG8_SCHED; PG8_LDA(At, 1, 0); PG8_STAGE(PG8_SA(0, 1), a2 + hstepA, voffA);
            PG8_WAIT_L(8); PG8_BAR; PG8_WAIT_L(0); PG8_MMA(0, 0, At, B0); PG8_BAR; PG8_SCHED;
            PG8_LDB(B1, 1, 1); PG8_STAGE(PG8_SB(1, 0), b3, voffB);
            PG8_BAR; PG8_WAIT_L(0); PG8_MMA(0, 1, At, B1); PG8_BAR;
            PG8_LDA(At, 1, 1); PG8_STAGE(PG8_SA(1, 0), a3, voffA);
            PG8_BAR; PG8_WAIT_L(0); PG8_MMA(1, 0, At, B0); PG8_BAR; PG8_SCHED;
            PG8_STAGE(PG8_SB(1, 1), b3 + hstep, voffB);
            PG8_WAIT_V(6); PG8_BAR; PG8_MMA(1, 1, At, B1); PG8_BAR;
        }
        if constexpr (!Epi::AFTER_DRAIN) E(acc, cur, wr, wc, fr, fq);
        if (!has_next) break;
#pragma unroll
        for (int a = 0; a < 2; ++a)
#pragma unroll
            for (int b = 0; b < 2; ++b)
#pragma unroll
                for (int m = 0; m < 4; ++m)
#pragma unroll
                    for (int n = 0; n < 2; ++n) acc[a][b][m][n] = (f32x4){0.f, 0.f, 0.f, 0.f};
        cur = nxt; cA = nA; cB = nB; ++ui;
    }
    PG8_WAIT_V(0);
    if (wr == 0) PG8_BAR;
    PG8_BAR;
    if constexpr (Epi::AFTER_DRAIN) E.fused(acc, cur, wr, wc, fr, fq, lds, wid, lane);
#undef PG8_AOFF
#undef PG8_AK
#undef PG8_SA
#undef PG8_SB
#undef PG8_STAGE
#undef PG8_LDA
#undef PG8_LDB
#undef PG8_MMA
#undef PG8_WAIT_V
#undef PG8_WAIT_L
#undef PG8_BAR
#undef PG8_SCHED
}
}
using pg8::Unit;
typedef f32x4 AccT[2][2][4][2];

struct EpiWin {
    static constexpr int ID = 1;
    static constexpr bool PERM = true, AFTER_DRAIN = false;
    bf16_t* gb; bf16_t* vv;
    __device__ __forceinline__ void operator()(const AccT& acc, const Unit& u, int wr, int wc, int fr, int fq) const {
        const int row0 = u.pm * 256 + wr * 64 + fr, cb = wc * 32 + 8 * fq;
        if (u.pn < 8) {
#pragma unroll
            for (int ai = 0; ai < 2; ++ai)
#pragma unroll
                for (int m = 0; m < 4; ++m) { bf16_t* rowp = gb + (size_t)(row0 + ai * 128 + m * 16) * DM + u.pn * 256 + cb;
#pragma unroll
                    for (int bj = 0; bj < 2; ++bj) { const f32x4 v0 = acc[ai][bj][m][0], v1 = acc[ai][bj][m][1];
                        u32x4 w; w.x = pk_bf16(v0[0], v0[1]); w.y = pk_bf16(v0[2], v0[3]); w.z = pk_bf16(v1[0], v1[1]); w.w = pk_bf16(v1[2], v1[3]);
                        *(u32x4*)(rowp + bj * 128) = w; } }
        } else {
            const int j = u.pn - 8;
#pragma unroll
            for (int ai = 0; ai < 2; ++ai)
#pragma unroll
                for (int m = 0; m < 4; ++m) { bf16_t* rowp = vv + (size_t)(row0 + ai * 128 + m * 16) * DM + j * 128 + cb;
                    const f32x4 v0 = acc[ai][0][m][0] * acc[ai][1][m][0], v1 = acc[ai][0][m][1] * acc[ai][1][m][1];
                    u32x4 w; w.x = pk_bf16(v0[0], v0[1]); w.y = pk_bf16(v0[2], v0[3]); w.z = pk_bf16(v1[0], v1[1]); w.w = pk_bf16(v1[2], v1[3]);
                    *(u32x4*)rowp = w; }
        }
    }
};
struct EpiZ {
    static constexpr int ID = 2;
    static constexpr bool PERM = false, AFTER_DRAIN = false;
    const float* res; float* z;
    __device__ __forceinline__ void operator()(const AccT& acc, const Unit& u, int wr, int wc, int fr, int fq) const {
        const int row0 = u.pm * 256 + wr * 64 + fr, col0 = u.pn * 256 + wc * 32 + 4 * fq;
#pragma unroll
        for (int ai = 0; ai < 2; ++ai)
#pragma unroll
            for (int m = 0; m < 4; ++m) { const size_t off = (size_t)(row0 + ai * 128 + m * 16) * DM + col0;
#pragma unroll
                for (int bj = 0; bj < 2; ++bj)
#pragma unroll
                    for (int n = 0; n < 2; ++n) { const f32x4 r = *(const f32x4*)(res + off + bj * 128 + n * 16);
                        *(f32x4*)(z + off + bj * 128 + n * 16) = r * ALPHA + acc[ai][bj][m][n]; }
                asm volatile("" ::: "memory"); }
    }
};
struct EpiRelu2 {
    static constexpr int ID = 4;
    static constexpr bool PERM = true, AFTER_DRAIN = false;
    bf16_t* o;
    __device__ __forceinline__ void operator()(const AccT& acc, const Unit& u, int wr, int wc, int fr, int fq) const {
        const int row0 = u.pm * 256 + wr * 64 + fr, col0 = u.pn * 256 + wc * 32 + 8 * fq;
#pragma unroll
        for (int ai = 0; ai < 2; ++ai)
#pragma unroll
            for (int m = 0; m < 4; ++m) { bf16_t* rowp = o + (size_t)(u.pm * 32 + u.pn) * 65536 + (unsigned)((wr * 64 + fr + ai * 128 + m * 16) * 256 + wc * 32 + 8 * fq);
#pragma unroll
                for (int bj = 0; bj < 2; ++bj) { f32x4 v0 = acc[ai][bj][m][0], v1 = acc[ai][bj][m][1];
#pragma unroll
                    for (int e = 0; e < 4; ++e) { const float a = fmaxf(v0[e], 0.f), b = fmaxf(v1[e], 0.f); v0[e] = a * a; v1[e] = b * b; }
                    u32x4 w; w.x = pk_bf16(v0[0], v0[1]); w.y = pk_bf16(v0[2], v0[3]); w.z = pk_bf16(v1[0], v1[1]); w.w = pk_bf16(v1[2], v1[3]);
                    *(u32x4*)(rowp + bj * 128) = w; } }
    }
};
template <int ldc> struct EpiF32 {
    static constexpr int ID = 8;
    static constexpr bool PERM = false, AFTER_DRAIN = false;
    float* C;
    __device__ __forceinline__ void operator()(const AccT& acc, const Unit& u, int wr, int wc, int fr, int fq) const {
        const int row0 = u.pm * 256 + wr * 64 + fr, col0 = u.pn * 256 + wc * 32 + 4 * fq;
#pragma unroll
        for (int ai = 0; ai < 2; ++ai)
#pragma unroll
            for (int m = 0; m < 4; ++m) { float* rowp = C + (size_t)(row0 + ai * 128 + m * 16) * ldc + col0;
#pragma unroll
                for (int bj = 0; bj < 2; ++bj)
#pragma unroll
                    for (int n = 0; n < 2; ++n) *(f32x4*)(rowp + bj * 128 + n * 16) = acc[ai][bj][m][n]; }
    }
};
template <int ldc> struct EpiBf16 {
    static constexpr int ID = 16;
    static constexpr bool PERM = true, AFTER_DRAIN = false;
    bf16_t* o;
    __device__ __forceinline__ void operator()(const AccT& acc, const Unit& u, int wr, int wc, int fr, int fq) const {
        const int row0 = u.pm * 256 + wr * 64 + fr, col0 = u.pn * 256 + wc * 32 + 8 * fq;
#pragma unroll
        for (int ai = 0; ai < 2; ++ai)
#pragma unroll
            for (int m = 0; m < 4; ++m) { bf16_t* rowp = o + (size_t)(row0 + ai * 128 + m * 16) * ldc + col0;
#pragma unroll
                for (int bj = 0; bj < 2; ++bj) { const f32x4 v0 = acc[ai][bj][m][0], v1 = acc[ai][bj][m][1];
                    u32x4 w; w.x = pk_bf16(v0[0], v0[1]); w.y = pk_bf16(v0[2], v0[3]); w.z = pk_bf16(v1[0], v1[1]); w.w = pk_bf16(v1[2], v1[3]);
                    *(u32x4*)(rowp + bj * 128) = w; } }
    }
};
struct EpiQ {
    static constexpr int ID = 32;
    static constexpr bool PERM = true, AFTER_DRAIN = false;
    bf16_t* o; const float* cosT; const float* sinT;
    __device__ __forceinline__ void operator()(const AccT& acc, const Unit& u, int wr, int wc, int fr, int fq) const {
        const int row0 = u.pm * 256 + wr * 64 + fr, col0 = u.pn * 256 + wc * 32 + 8 * fq;
        if (u.pn < 8) {
#pragma unroll
            for (int ai = 0; ai < 2; ++ai)
#pragma unroll
                for (int m = 0; m < 4; ++m) { bf16_t* rowp = o + (size_t)(row0 + ai * 128 + m * 16) * 3072 + col0;
#pragma unroll
                    for (int bj = 0; bj < 2; ++bj) { const f32x4 v0 = acc[ai][bj][m][0] * QSCALE, v1 = acc[ai][bj][m][1] * QSCALE;
                        u32x4 w; w.x = pk_bf16(v0[0], v0[1]); w.y = pk_bf16(v0[2], v0[3]); w.z = pk_bf16(v1[0], v1[1]); w.w = pk_bf16(v1[2], v1[3]);
                        *(u32x4*)(rowp + bj * 128) = w; } }
        } else {
#pragma unroll
            for (int ai = 0; ai < 2; ++ai)
#pragma unroll
                for (int m = 0; m < 4; ++m) { const int row = row0 + ai * 128 + m * 16; const int pos = row & (SEQ - 1);
                    bf16_t* rowp = o + (size_t)row * 3072 + col0;
#pragma unroll
                    for (int bj = 0; bj < 2; ++bj) { const int p0 = (col0 + bj * 128) & 63, j = p0 >> 3;
                        const f32x4 cs = *(const f32x4*)(cosT + pos * 32 + 4 * j) * QSCALE, sn = *(const f32x4*)(sinT + pos * 32 + 4 * j) * QSCALE;
                        const f32x4 x1 = acc[ai][bj][m][0], x2 = acc[ai][bj][m][1];
                        const f32x4 v0 = x1 * cs - x2 * sn, v1 = x2 * cs + x1 * sn;
                        u32x4 w; w.x = pk_bf16(v0[0], v0[1]); w.y = pk_bf16(v0[2], v0[3]); w.z = pk_bf16(v1[0], v1[1]); w.w = pk_bf16(v1[2], v1[3]);
                        *(u32x4*)(rowp + bj * 128) = w; } }
        }
    }
};


struct EpiZLn {
    static constexpr int ID = 2;
    static constexpr bool PERM = true, AFTER_DRAIN = true;
    const bf16_t* res; const float* g; const float* b; float* hout; bf16_t* hb; unsigned long long* xbuf; unsigned* cnt;
    __device__ __forceinline__ void fused(AccT& acc, const Unit& u, int wr, int wc, int fr, int fq, LAS unsigned char* lds, int wid, int lane) const {
        LAS f32x2* P = (LAS f32x2*)lds;
        LAS f32x2* S = (LAS f32x2*)(lds + 8192);
        const int row0 = u.pm * 256 + wr * 64 + fr, col0 = u.pn * 256 + wc * 32 + 8 * fq;
#pragma unroll
        for (int ai = 0; ai < 2; ++ai) {
            u32x4 rr[4][2];
#pragma unroll
            for (int m = 0; m < 4; ++m) { const size_t off = (size_t)(row0 + ai * 128 + m * 16) * DM + col0;
#pragma unroll
                for (int bj = 0; bj < 2; ++bj) rr[m][bj] = *(const u32x4*)(res + off + bj * 128); }
            asm volatile("" : "+v"(rr[0][0]), "+v"(rr[0][1]), "+v"(rr[1][0]), "+v"(rr[1][1]), "+v"(rr[2][0]), "+v"(rr[2][1]), "+v"(rr[3][0]), "+v"(rr[3][1]));
#pragma unroll
            for (int m = 0; m < 4; ++m) {
#pragma unroll
                for (int bj = 0; bj < 2; ++bj) { const u32x4 r = rr[m][bj];
                    acc[ai][bj][m][0] = (f32x4){bf_lo(r.x), bf_hi(r.x), bf_lo(r.y), bf_hi(r.y)} * ALPHA + acc[ai][bj][m][0];
                    acc[ai][bj][m][1] = (f32x4){bf_lo(r.z), bf_hi(r.z), bf_lo(r.w), bf_hi(r.w)} * ALPHA + acc[ai][bj][m][1]; }
                asm volatile("" : "+v"(acc[ai][0][m][0]), "+v"(acc[ai][0][m][1]), "+v"(acc[ai][1][m][0]), "+v"(acc[ai][1][m][1])); }
        }
        f32x4 gq[2][2], bq[2][2];
#pragma unroll
        for (int bj = 0; bj < 2; ++bj) { gq[bj][0] = *(const f32x4*)(g + col0 + bj * 128); gq[bj][1] = *(const f32x4*)(g + col0 + bj * 128 + 4); bq[bj][0] = *(const f32x4*)(b + col0 + bj * 128); bq[bj][1] = *(const f32x4*)(b + col0 + bj * 128 + 4); }
#pragma unroll
        for (int ai = 0; ai < 2; ++ai)
#pragma unroll
            for (int m = 0; m < 4; ++m) {
                float sm = 0.f;
#pragma unroll
                for (int bj = 0; bj < 2; ++bj)
#pragma unroll
                    for (int n = 0; n < 2; ++n) { const f32x4 x = acc[ai][bj][m][n]; sm += (x[0] + x[1]) + (x[2] + x[3]); }
                sm += __shfl_xor(sm, 16); sm += __shfl_xor(sm, 32);
                const float mw = sm * (1.0f / 64.0f); float q = 0.f;
#pragma unroll
                for (int bj = 0; bj < 2; ++bj)
#pragma unroll
                    for (int n = 0; n < 2; ++n) { const f32x4 d = acc[ai][bj][m][n] - mw; q += (d[0] * d[0] + d[1] * d[1]) + (d[2] * d[2] + d[3] * d[3]); }
                q += __shfl_xor(q, 16); q += __shfl_xor(q, 32);
                if (fq == 0) P[(ai * 128 + wr * 64 + m * 16 + fr) * 4 + wc] = (f32x2){mw, q};
            }
        asm volatile("s_waitcnt lgkmcnt(0)" ::: "memory"); __builtin_amdgcn_s_barrier(); asm volatile("" ::: "memory");
        const int row = wid * 32 + (lane & 31);
        if (lane < 32) {
            const f32x2 a = P[row * 4 + 0], bq = P[row * 4 + 1], c = P[row * 4 + 2], d = P[row * 4 + 3];
            const float mt = (a.x + bq.x + c.x + d.x) * 0.25f;
            const float da = a.x - mt, db = bq.x - mt, dc = c.x - mt, dd = d.x - mt;
            const float m2 = (a.y + bq.y) + (c.y + d.y) + 64.0f * ((da * da + db * db) + (dc * dc + dd * dd));
            unsigned long long* slot = xbuf + ((size_t)(u.pm * 256 + row) * 8 + u.pn);
            __hip_atomic_store(slot, ((unsigned long long)__float_as_uint(m2) << 32) | __float_as_uint(mt), __ATOMIC_RELAXED, __HIP_MEMORY_SCOPE_AGENT);
        }
        asm volatile("s_waitcnt vmcnt(0)" ::: "memory");
        if (lane == 0) __hip_atomic_fetch_add(cnt + 64 * u.pm, 1u, __ATOMIC_RELAXED, __HIP_MEMORY_SCOPE_AGENT);
        if (wid == 0) {
            unsigned sp = 0;
            while ((unsigned)__builtin_amdgcn_readfirstlane(__hip_atomic_load(cnt + 64 * u.pm, __ATOMIC_RELAXED, __HIP_MEMORY_SCOPE_AGENT)) < 64u) {
                __builtin_amdgcn_s_sleep(1); if (++sp > (1u << 22)) break; }
            __builtin_amdgcn_fence(__ATOMIC_ACQUIRE, "agent");
        }
        asm volatile("s_waitcnt vmcnt(0) lgkmcnt(0)" ::: "memory"); __builtin_amdgcn_s_barrier(); asm volatile("" ::: "memory");
        if (lane < 32) {
            const unsigned long long* slot = xbuf + (size_t)(u.pm * 256 + row) * 8; float mt[8], m2[8]; float ms = 0.f;
#pragma unroll
            for (int t = 0; t < 8; ++t) { const unsigned long long w = __hip_atomic_load(slot + t, __ATOMIC_RELAXED, __HIP_MEMORY_SCOPE_AGENT); mt[t] = __uint_as_float((unsigned)w); m2[t] = __uint_as_float((unsigned)(w >> 32)); ms += mt[t]; }
            const float mean = ms * 0.125f; float q = 0.f;
#pragma unroll
            for (int t = 0; t < 8; ++t) { const float dm = mt[t] - mean; q += m2[t] + 256.0f * dm * dm; }
            S[row] = (f32x2){mean, rsqrtf(q * (1.0f / DM) + LN_EPS)};
        }
        asm volatile("s_waitcnt lgkmcnt(0)" ::: "memory"); __builtin_amdgcn_s_barrier(); asm volatile("" ::: "memory");
#pragma unroll
        for (int bj = 0; bj < 2; ++bj) {
            const f32x4 g0 = gq[bj][0], g1 = gq[bj][1], b0 = bq[bj][0], b1 = bq[bj][1];
#pragma unroll
            for (int ai = 0; ai < 2; ++ai)
#pragma unroll
                for (int m = 0; m < 4; ++m) { const int r = ai * 128 + wr * 64 + m * 16 + fr; const f32x2 sr = S[r]; const size_t off = (size_t)(u.pm * 256 + r) * DM + col0 + bj * 128;
                    const f32x4 y0 = (acc[ai][bj][m][0] - sr.x) * sr.y * g0 + b0, y1 = (acc[ai][bj][m][1] - sr.x) * sr.y * g1 + b1;
                    if (hout) { *(f32x4*)(hout + off) = y0; *(f32x4*)(hout + off + 4) = y1; }
                    else { u32x4 w; w.x = pk_bf16(y0[0], y0[1]); w.y = pk_bf16(y0[2], y0[3]); w.z = pk_bf16(y1[0], y1[1]); w.w = pk_bf16(y1[2], y1[3]); *(u32x4*)(hb + off) = w; } }
            asm volatile("" ::: "memory"); }
    }
};

template <int M, int N, int K, class Epi>
__device__ __forceinline__ void run_gemm(LAS unsigned char* lds, const bf16_t* A, const bf16_t* Bt, const Epi& E) {
    pg8::Gemm g{A, Bt, M, N, K}; pg8::StaticOrder S; S.init(M, N, (int)gridDim.x, (int)blockIdx.x);
    if constexpr ((PH_MASK & 8) && (EPI_MASK & Epi::ID)) pg8::gemm_phase<Epi, K>(lds, g, S, E);
    if constexpr ((DUP_MASK & 8) && (DUP_EPI & Epi::ID)) pg8::gemm_phase<Epi, K>(lds, g, S, E);
}


#define XB_TMO      128
#define XB_XCNT(j)  (256  + 64 * (j))
#define XB_XSUB(j)  (1280 + 64 * (j))
#define XB_XGEN(j)  (2304 + 64 * (j))
#define XB_TOP      3328
#define XB_TOPGEN   3392
#define XCD_BAR_WORDS 3456
#define XB_SPIN_CAP (1u << 22)
__device__ __forceinline__ unsigned xb_ld(unsigned* p)              { return __hip_atomic_load(p, __ATOMIC_RELAXED, __HIP_MEMORY_SCOPE_AGENT); }
__device__ __forceinline__ unsigned xb_add(unsigned* p, unsigned v) { return __hip_atomic_fetch_add(p, v, __ATOMIC_RELAXED, __HIP_MEMORY_SCOPE_AGENT); }
__device__ __forceinline__ unsigned xb_xcc_id() { return (unsigned)__builtin_amdgcn_s_getreg((3 << 11) | 20) & 0xFu; }
#define XB_SPIN(cond, bar) do { unsigned _sp = 0; while (cond) { __builtin_amdgcn_s_sleep(1); \
    if ((++_sp & 255u) == 0u) { if (xb_ld(&(bar)[XB_TMO])) break; if (_sp > XB_SPIN_CAP) { atomicAdd(&(bar)[XB_TMO], 1u); break; } } } } while (0)
struct XcdBarrier { unsigned* bar; unsigned x; volatile LAS unsigned* st; };
__device__ __forceinline__ XcdBarrier xcd_barrier_post(unsigned* bar, volatile LAS unsigned* st) {
    XcdBarrier b; b.bar = bar; b.x = xb_xcc_id(); b.st = st;
    if (threadIdx.x == 0) (void)xb_add(&bar[XB_XCNT(b.x)], 1u);
    return b;
}
__device__ __forceinline__ void xcd_barrier_complete(unsigned* bar, unsigned x, unsigned& nloc, unsigned& nx) {
    const unsigned G = gridDim.x * gridDim.y * gridDim.z;
    unsigned sum, cnt, mine, sp = 0u;
    for (;;) {
        sum = 0u; cnt = 0u; mine = 0u;
#pragma unroll
        for (unsigned j = 0; j < 16; ++j) { const unsigned c = xb_ld(&bar[XB_XCNT(j)]); sum += c; cnt += (c > 0u) ? 1u : 0u; mine = (j == x) ? c : mine; }
        if (sum == G) break;
        __builtin_amdgcn_s_sleep(1);
        if ((++sp & 255u) == 0u) { if (xb_ld(&bar[XB_TMO])) break; if (sp > XB_SPIN_CAP) { atomicAdd(&bar[XB_TMO], 1u); break; } }
    }
    nloc = mine > 0u ? mine : 1u; nx = cnt > 0u ? cnt : 1u;
}
__device__ __forceinline__ void xcd_barrier(const XcdBarrier& b) {
    asm volatile("s_waitcnt vmcnt(0)" ::: "memory");
    __syncthreads();
    if (threadIdx.x == 0) {
        unsigned* bar = b.bar;
        __builtin_amdgcn_s_waitcnt(0);
        unsigned nloc = b.st[0], nx = b.st[1];
        if (nloc == 0u) { xcd_barrier_complete(bar, b.x, nloc, nx); b.st[0] = nloc; b.st[1] = nx; }
        const unsigned old = xb_add(&bar[XB_XSUB(b.x)], 1u);
        const unsigned gen = old / nloc;
        if (old + 1u == (gen + 1u) * nloc) {
            __builtin_amdgcn_fence(__ATOMIC_RELEASE, "agent");
            asm volatile("s_waitcnt vmcnt(0)" ::: "memory");
            const unsigned og = xb_add(&bar[XB_TOP], 1u);
            const unsigned tg = og / nx;
            if (og + 1u == (tg + 1u) * nx) xb_add(&bar[XB_TOPGEN], 1u);
            else XB_SPIN(xb_ld(&bar[XB_TOPGEN]) == tg, bar);
            __builtin_amdgcn_fence(__ATOMIC_ACQUIRE, "agent");
            xb_add(&bar[XB_XGEN(b.x)], 1u);
            asm volatile("s_waitcnt vmcnt(0)" ::: "memory");
        } else {
            XB_SPIN(xb_ld(&bar[XB_XGEN(b.x)]) == gen, bar);
            __builtin_amdgcn_fence(__ATOMIC_ACQUIRE, "agent");
            asm volatile("s_waitcnt vmcnt(0)" ::: "memory");
        }
    }
    __syncthreads();
}

struct Job { const float* src; bf16_t* dst; int K, pitch, ntn, type, tstart, pad; };
struct Params {
    const float* x; const float* ln_g; const float* ln_b; const float* conv_w; const float* kv_norm_g; const float* q_norm_g;
    float* out;
    bf16_t* win; bf16_t* wout; bf16_t* wdqkv; bf16_t* wdq3; bf16_t* wk; bf16_t* wv; bf16_t* wuq; bf16_t* wo; bf16_t* w1; bf16_t* w2;
    bf16_t* hb; float* ha; float* z; bf16_t* a1; bf16_t* gb; bf16_t* vv; bf16_t* gg; bf16_t* qb; bf16_t* ob;
    unsigned* bar; unsigned long long cg_flag; unsigned long long* xbuf; unsigned* lncnt;
    float* cqkv; bf16_t* cqn; bf16_t* ckv; bf16_t* kpe; bf16_t* kn; bf16_t* vt; float* cosT; float* sinT;
    Job jobs[NJOBS];
};

__device__ __forceinline__ int permcol(int type, int n) {
    if (type == 1) { if (n < 2048) return n; const int r = n - 2048, t = r >> 8, w = r & 255, bj = w >> 7; return 2048 + bj * 2048 + t * 128 + (w & 127); }
    if (type == 2) { if (n < 2048) return (n >> 7) * 192 + (n & 127); const int r = n - 2048, hd = r >> 6, p = r & 63, j = p >> 3, e = p & 7;
        const int dim = e < 4 ? 4 * j + e : 32 + 4 * j + (e - 4); return hd * 192 + 128 + dim; }
    if (type == 3) return (n >> 7) * 256 + (n & 127);
    if (type == 4) return (n >> 7) * 256 + 128 + (n & 127);
    return n;
}

__device__ __forceinline__ void convert_phase(const Params& p, LAS unsigned char* lds) {
    int tid = threadIdx.x; asm volatile("" : "+v"(tid));
    LAS bf16_t* Tt = (LAS bf16_t*)lds;
    {
        const int total = p.jobs[NJOBS - 1].tstart + p.jobs[NJOBS - 1].ntn * (p.jobs[NJOBS - 1].K >> 8);
        for (int gtile = blockIdx.x; gtile < total; gtile += gridDim.x) {
            int j = 0;
#pragma unroll 1
            for (int jj = 1; jj < NJOBS; ++jj) if (gtile >= p.jobs[jj].tstart) j = jj;
            const float* src = p.jobs[j].src; bf16_t* dst = p.jobs[j].dst; const int K = p.jobs[j].K, pitch = p.jobs[j].pitch, type = p.jobs[j].type;
            const int ntk = K >> 8, t = gtile - p.jobs[j].tstart;
            const int tn = t / ntk, tk = t - tn * ntk, n0 = tn * 64, k0 = tk * 256;
            const int c4 = tid & 15, kk = tid >> 4;
            const int col = permcol(type, n0 + 4 * c4);
            f32x4 v[8];
#pragma unroll
            for (int i = 0; i < 8; ++i) v[i] = __builtin_nontemporal_load((const f32x4*)(src + (size_t)(k0 + kk + 32 * i) * pitch + col));
#pragma unroll
            for (int i = 0; i < 8; ++i) { const int k = kk + 32 * i;
                const unsigned w0 = pk_bf16(v[i][0], v[i][1]), w1 = pk_bf16(v[i][2], v[i][3]);
                Tt[(4 * c4 + 0) * 264 + k] = (bf16_t)(w0 & 0xffffu); Tt[(4 * c4 + 1) * 264 + k] = (bf16_t)(w0 >> 16);
                Tt[(4 * c4 + 2) * 264 + k] = (bf16_t)(w1 & 0xffffu); Tt[(4 * c4 + 3) * 264 + k] = (bf16_t)(w1 >> 16); }
            __syncthreads();
#pragma unroll
            for (int i = 0; i < 4; ++i) { const int c = tid + 512 * i, nn = c >> 5, kc = c & 31; const u32x4 w = *(const LAS u32x4*)(Tt + nn * 264 + 8 * kc);
              *(u32x4*)(dst + (size_t)(n0 + nn) * K + k0 + 8 * kc) = w; }
            __syncthreads();
        }
    }
    const size_t gt = (size_t)blockIdx.x * 512 + tid, gs = (size_t)gridDim.x * 512;
    for (size_t i = gt; i < (size_t)T_TOK * DM / 8; i += 4 * gs) {
        f32x4 xa[4], xb[4];
#pragma unroll
        for (int u = 0; u < 4; ++u) { size_t ii = i + u * gs; if (ii >= (size_t)T_TOK * DM / 8) ii = i; xa[u] = __builtin_nontemporal_load((const f32x4*)(p.x + ii * 8)); xb[u] = __builtin_nontemporal_load((const f32x4*)(p.x + ii * 8 + 4)); }
        asm volatile("" : "+v"(xa[0]), "+v"(xa[1]), "+v"(xa[2]), "+v"(xa[3]), "+v"(xb[0]), "+v"(xb[1]), "+v"(xb[2]), "+v"(xb[3]));
#pragma unroll
        for (int u = 0; u < 4; ++u) { size_t ii = i + u * gs; if (ii >= (size_t)T_TOK * DM / 8) ii = i; const f32x4 a = xa[u], b = xb[u];
            u32x4 w; w.x = pk_bf16(a[0], a[1]); w.y = pk_bf16(a[2], a[3]); w.z = pk_bf16(b[0], b[1]); w.w = pk_bf16(b[2], b[3]); *(u32x4*)(p.hb + ii * 8) = w; }
    }
    for (size_t i = gt; i < (size_t)192 * DM / 8; i += gs) *(u32x4*)(p.wdqkv + (size_t)1088 * DM + i * 8) = (u32x4){0u, 0u, 0u, 0u};
    for (size_t i = gt; i < (size_t)SEQ * 32; i += gs) { const int pos = (int)(i >> 5), fi = (int)(i & 31);
        const float inv = 1.0f / powf(10000.0f, (float)(2 * fi) / 64.0f); const float ang = (float)pos * inv;
        double rev = (double)ang * 0.15915494309189535; rev -= rint(rev); const float fr = (float)rev;
        p.cosT[i] = __builtin_amdgcn_cosf(fr); p.sinT[i] = __builtin_amdgcn_sinf(fr); }
}

__device__ __forceinline__ float wave_sum(float v) {
#pragma unroll
    for (int o = 32; o >= 1; o >>= 1) v += __shfl_xor(v, o);
    return v;
}

__device__ __forceinline__ void ln_phase(const float* z, const float* g, const float* b, float* hout, bf16_t* hb) {
    int tid = threadIdx.x; asm volatile("" : "+v"(tid));
    const int wid = tid >> 6, lane = tid & 63;
    for (int row = blockIdx.x * 8 + wid; row < T_TOK; row += gridDim.x * 8) {
        const float* zr = z + (size_t)row * DM;
        f32x4 v[8]; float s = 0.f;
#pragma unroll
        for (int i = 0; i < 8; ++i) { v[i] = *(const f32x4*)(zr + 4 * lane + 256 * i); s += (v[i][0] + v[i][1]) + (v[i][2] + v[i][3]); }
        const float mu = wave_sum(s) * (1.0f / DM);
        float q = 0.f;
#pragma unroll
        for (int i = 0; i < 8; ++i) { const f32x4 d = v[i] - mu; q += (d[0] * d[0] + d[1] * d[1]) + (d[2] * d[2] + d[3] * d[3]); }
        const float rstd = rsqrtf(wave_sum(q) * (1.0f / DM) + LN_EPS);
#pragma unroll
        for (int i = 0; i < 8; ++i) { const int col = 4 * lane + 256 * i; const f32x4 gv = *(const f32x4*)(g + col), bv = *(const f32x4*)(b + col);
            const f32x4 y = (v[i] - mu) * rstd * gv + bv;
            if (hout) *(f32x4*)(hout + (size_t)row * DM + col) = y;
            if (hb) { u32x2 w; w.x = pk_bf16(y[0], y[1]); w.y = pk_bf16(y[2], y[3]); *(u32x2*)(hb + (size_t)row * DM + col) = w; } }
    }
}

__device__ __forceinline__ void conv_phase(const bf16_t* gb, const bf16_t* vv, const float* cw, bf16_t* out) {
    int tid = threadIdx.x; asm volatile("" : "+v"(tid));
    const int cgp = tid & 255, rr = tid >> 8;
    float w0[8], w1[8], w2[8];
#pragma unroll
    for (int e = 0; e < 8; ++e) { w0[e] = cw[cgp * 8 + e]; w1[e] = cw[DM + cgp * 8 + e]; w2[e] = cw[2 * DM + cgp * 8 + e]; }
    for (int it = blockIdx.x; it < T_TOK / 32; it += gridDim.x) {
        const int t0 = it * 32 + rr * 16;
        float p2[8], p1[8];
        if ((t0 & (SEQ - 1)) == 0) {
#pragma unroll
            for (int e = 0; e < 8; ++e) { p2[e] = 0.f; p1[e] = 0.f; }
        } else {
            const u32x4 a = *(const u32x4*)(vv + (size_t)(t0 - 2) * DM + cgp * 8), b = *(const u32x4*)(vv + (size_t)(t0 - 1) * DM + cgp * 8);
#pragma unroll
            for (int e = 0; e < 4; ++e) { p2[2 * e] = bf_lo(a[e]); p2[2 * e + 1] = bf_hi(a[e]); p1[2 * e] = bf_lo(b[e]); p1[2 * e + 1] = bf_hi(b[e]); }
        }
#pragma unroll 1
        for (int tb = t0; tb < t0 + 16; tb += 8) {
            u32x4 cc[8], gq[8];
#pragma unroll
            for (int rr = 0; rr < 8; ++rr) { cc[rr] = *(const u32x4*)(vv + (size_t)(tb + rr) * DM + cgp * 8); gq[rr] = *(const u32x4*)(gb + (size_t)(tb + rr) * DM + cgp * 8); }
            asm volatile("" : "+v"(cc[0]), "+v"(cc[1]), "+v"(cc[2]), "+v"(cc[3]), "+v"(cc[4]), "+v"(cc[5]), "+v"(cc[6]), "+v"(cc[7]),
                              "+v"(gq[0]), "+v"(gq[1]), "+v"(gq[2]), "+v"(gq[3]), "+v"(gq[4]), "+v"(gq[5]), "+v"(gq[6]), "+v"(gq[7]));
#pragma unroll
            for (int rr = 0; rr < 8; ++rr) {
                float cur[8], gv[8], y[8];
#pragma unroll
                for (int e = 0; e < 4; ++e) { cur[2 * e] = bf_lo(cc[rr][e]); cur[2 * e + 1] = bf_hi(cc[rr][e]); gv[2 * e] = bf_lo(gq[rr][e]); gv[2 * e + 1] = bf_hi(gq[rr][e]); }
#pragma unroll
                for (int e = 0; e < 8; ++e) { y[e] = gv[e] * (w0[e] * p2[e] + w1[e] * p1[e] + w2[e] * cur[e]); p2[e] = p1[e]; p1[e] = cur[e]; }
                u32x4 w; w.x = pk_bf16(y[0], y[1]); w.y = pk_bf16(y[2], y[3]); w.z = pk_bf16(y[4], y[5]); w.w = pk_bf16(y[6], y[7]);
                *(u32x4*)(out + (size_t)(tb + rr) * DM + cgp * 8) = w;
            }
        }
    }
}

__device__ __forceinline__ void norm_phase(const float* src, int pitch, bool has_kv, const float* qg, const float* kvg,
                                           bf16_t* cqn, bf16_t* ckv, bf16_t* kpe, const float* cosT, const float* sinT) {
    int tid = threadIdx.x; asm volatile("" : "+v"(tid));
    const int wid = tid >> 6, lane = tid & 63;
#pragma unroll 4
    for (int row = blockIdx.x * 8 + wid; row < T_TOK; row += gridDim.x * 8) {
        const float* sr = src + (size_t)row * pitch;
        {
            const f32x4 a = *(const f32x4*)(sr + 8 * lane), b = *(const f32x4*)(sr + 8 * lane + 4);
            float s = (a[0] * a[0] + a[1] * a[1]) + (a[2] * a[2] + a[3] * a[3]) + (b[0] * b[0] + b[1] * b[1]) + (b[2] * b[2] + b[3] * b[3]);
            const float r = rsqrtf(wave_sum(s) * (1.0f / 512.0f) + RMS_EPS);
            const f32x4 ga = *(const f32x4*)(qg + 8 * lane), gb2 = *(const f32x4*)(qg + 8 * lane + 4);
            const f32x4 ya = a * r * ga, yb = b * r * gb2;
            u32x4 w; w.x = pk_bf16(ya[0], ya[1]); w.y = pk_bf16(ya[2], ya[3]); w.z = pk_bf16(yb[0], yb[1]); w.w = pk_bf16(yb[2], yb[3]);
            *(u32x4*)(cqn + (size_t)row * 512 + 8 * lane) = w;
        }
        if (has_kv) {
            const f32x4 a = *(const f32x4*)(sr + 512 + 8 * lane), b = *(const f32x4*)(sr + 512 + 8 * lane + 4);
            float s = (a[0] * a[0] + a[1] * a[1]) + (a[2] * a[2] + a[3] * a[3]) + (b[0] * b[0] + b[1] * b[1]) + (b[2] * b[2] + b[3] * b[3]);
            const float r = rsqrtf(wave_sum(s) * (1.0f / 512.0f) + RMS_EPS);
            const f32x4 ga = *(const f32x4*)(kvg + 8 * lane), gb2 = *(const f32x4*)(kvg + 8 * lane + 4);
            const f32x4 ya = a * r * ga, yb = b * r * gb2;
            u32x4 w; w.x = pk_bf16(ya[0], ya[1]); w.y = pk_bf16(ya[2], ya[3]); w.z = pk_bf16(yb[0], yb[1]); w.w = pk_bf16(yb[2], yb[3]);
            *(u32x4*)(ckv + (size_t)row * 512 + 8 * lane) = w;
            if (lane < 32) {
                const int pos = row & (SEQ - 1);
                const float x1 = sr[1024 + lane], x2 = sr[1024 + 32 + lane];
                const float cs = cosT[pos * 32 + lane], sn = sinT[pos * 32 + lane];
                const float o1 = x1 * cs - x2 * sn, o2 = x2 * cs + x1 * sn;
                const int pp = 8 * (lane >> 2) + (lane & 3);
                kpe[(size_t)row * 64 + pp] = (bf16_t)(pk_bf16(o1, 0.f) & 0xffffu);
                kpe[(size_t)row * 64 + pp + 4] = (bf16_t)(pk_bf16(o2, 0.f) & 0xffffu);
            }
        }
    }
}

__device__ __forceinline__ void norm_phase_split(const bf16_t* part, const float* qg, bf16_t* cqn) {
    int tid = threadIdx.x; asm volatile("" : "+v"(tid));
    const int wid = tid >> 6, lane = tid & 63;
#pragma unroll 4
    for (int row = blockIdx.x * 8 + wid; row < T_TOK; row += gridDim.x * 8) {
        const bf16_t* sr = part + (size_t)row * 2048 + 8 * lane;
        float x[8];
#pragma unroll
        for (int e = 0; e < 8; ++e) x[e] = 0.f;
#pragma unroll
        for (int sp = 0; sp < 4; ++sp) { const u32x4 w = *(const u32x4*)(sr + sp * 512);
#pragma unroll
            for (int e = 0; e < 4; ++e) { x[2 * e] += bf_lo(w[e]); x[2 * e + 1] += bf_hi(w[e]); } }
        float ss = 0.f;
#pragma unroll
        for (int e = 0; e < 8; ++e) ss += x[e] * x[e];
        const float rr = rsqrtf(wave_sum(ss) * (1.0f / 512.0f) + RMS_EPS);
        const f32x4 ga = *(const f32x4*)(qg + 8 * lane), gb2 = *(const f32x4*)(qg + 8 * lane + 4);
        u32x4 w; w.x = pk_bf16(x[0] * rr * ga[0], x[1] * rr * ga[1]); w.y = pk_bf16(x[2] * rr * ga[2], x[3] * rr * ga[3]);
        w.z = pk_bf16(x[4] * rr * gb2[0], x[5] * rr * gb2[1]); w.w = pk_bf16(x[6] * rr * gb2[2], x[7] * rr * gb2[3]);
        *(u32x4*)(cqn + (size_t)row * 512 + 8 * lane) = w;
    }
}

constexpr int KROWB = 400, VROWB = 136, KBUF = 64 * KROWB, ABUF = KBUF + 128 * VROWB;
__device__ __forceinline__ void attn_block(LAS unsigned char* lds, const bf16_t* q, const bf16_t* kn, const bf16_t* kpe, const bf16_t* vt,
                                           bf16_t* o, int b, int h, int qb) {
    int tid = threadIdx.x; asm volatile("" : "+v"(tid));
    const int wid = __builtin_amdgcn_readfirstlane(tid >> 6), lane = tid & 63, r = lane & 31, hh = lane >> 5;
    const int q0 = qb * 256, qw0 = q0 + wid * 32;
    const int nt = (q0 + 256) >> 6;
    const size_t tokb = (size_t)b * SEQ;
    bf16x8 qf[12];
    { const bf16_t* qrow = q + (tokb + qw0 + r) * 3072;
#pragma unroll
      for (int ks = 0; ks < 8; ++ks) qf[ks] = *(const bf16x8*)(qrow + h * 128 + ks * 16 + hh * 8);
#pragma unroll
      for (int ks = 8; ks < 12; ++ks) qf[ks] = *(const bf16x8*)(qrow + 2048 + h * 64 + (ks - 8) * 16 + hh * 8); }
    f32x16 oacc[4];
#pragma unroll
    for (int d = 0; d < 4; ++d)
#pragma unroll
        for (int i = 0; i < 16; ++i) oacc[d][i] = 0.f;
    float mrun = -1e30f, lrun = 0.f;
    const bf16_t* knb = kn + tokb * DM + h * 128; const bf16_t* peb = kpe + tokb * 64; const bf16_t* vtb = vt + (size_t)h * 128 * T_TOK + tokb;
    const unsigned koff = (unsigned)((tid >> 4) * DM + (tid & 15) * 8), kdst = (unsigned)((tid >> 4) * KROWB + (tid & 15) * 16);
    const unsigned peoff = (unsigned)((tid >> 3) * 64 + (tid & 7) * 8), pedst = (unsigned)((tid >> 3) * KROWB + 256 + (tid & 7) * 16);
    const unsigned voff = (unsigned)((tid >> 3) * T_TOK + (tid & 7) * 8), vdst = (unsigned)(KBUF + (tid >> 3) * VROWB + (tid & 7) * 16);
    u32x4 kr[3], vr[2];
#define ATT_LOAD(t) do { const bf16_t* kt_ = knb + (size_t)(t) * 64 * DM; kr[0] = *(const u32x4*)(kt_ + koff); kr[1] = *(const u32x4*)(kt_ + koff + 32 * DM); \
        kr[2] = *(const u32x4*)(peb + (size_t)(t) * 64 * 64 + peoff); const bf16_t* vt_ = vtb + (size_t)(t) * 64; vr[0] = *(const u32x4*)(vt_ + voff); vr[1] = *(const u32x4*)(vt_ + voff + 64 * T_TOK); } while (0)
#define ATT_WRITE(bf_) do { LAS unsigned char* b_ = lds + (bf_) * ABUF; *(LAS u32x4*)(b_ + kdst) = kr[0]; *(LAS u32x4*)(b_ + kdst + 32 * KROWB) = kr[1]; *(LAS u32x4*)(b_ + pedst) = kr[2]; \
        _Pragma("unroll") for (int i = 0; i < 2; ++i) { *(LAS u32x2*)(b_ + vdst + i * 64 * VROWB) = (u32x2){vr[i].x, vr[i].y}; *(LAS u32x2*)(b_ + vdst + i * 64 * VROWB + 8) = (u32x2){vr[i].z, vr[i].w}; } } while (0)
    ATT_LOAD(0); ATT_WRITE(0);
    __builtin_amdgcn_s_waitcnt(0x0F70);
    __syncthreads();
    const int qrow = qw0 + r;
    for (int t = 0; t < nt; ++t) {
        const int buf = t & 1, kbase = t * 64;
        if (t + 1 < nt) ATT_LOAD(t + 1);
        if (kbase <= qw0 + 31) {
            LAS unsigned char* kb = lds + buf * ABUF; LAS unsigned char* vb = kb + KBUF;
            f32x16 s0, s1;
#pragma unroll
            for (int i = 0; i < 16; ++i) { s0[i] = 0.f; s1[i] = 0.f; }
            bf16x8 kf[3][4];
#define ATT_LDK(bufi, g) do { _Pragma("unroll") for (int ksl = 0; ksl < 2; ++ksl) { \
                kf[bufi][2 * ksl] = *(const LAS bf16x8*)(kb + r * KROWB + (((g) * 2 + ksl) * 16 + hh * 8) * 2); \
                kf[bufi][2 * ksl + 1] = *(const LAS bf16x8*)(kb + (32 + r) * KROWB + (((g) * 2 + ksl) * 16 + hh * 8) * 2); } } while (0)
            ATT_LDK(0, 0); ATT_LDK(1, 1);
            __builtin_amdgcn_sched_barrier(0);
#pragma unroll
            for (int g = 0; g < 6; ++g) {
                if (g + 2 < 6) ATT_LDK((g + 2) % 3, g + 2);
#pragma unroll
                for (int ksl = 0; ksl < 2; ++ksl) {
                    s0 = __builtin_amdgcn_mfma_f32_32x32x16_bf16(kf[g % 3][2 * ksl], qf[g * 2 + ksl], s0, 0, 0, 0);
                    s1 = __builtin_amdgcn_mfma_f32_32x32x16_bf16(kf[g % 3][2 * ksl + 1], qf[g * 2 + ksl], s1, 0, 0, 0);
                }
                __builtin_amdgcn_sched_barrier(0);
            }
#undef ATT_LDK
            if (kbase + 63 > qw0) {
                asm volatile("" ::: "memory");
#pragma unroll
                for (int i = 0; i < 16; ++i) { const int key = kbase + (i >> 2) * 8 + hh * 4 + (i & 3);
                    if (key > qrow) s0[i] = -INFINITY; if (key + 32 > qrow) s1[i] = -INFINITY; }
            }
            float mx = s0[0];
#pragma unroll
            for (int i = 1; i < 16; ++i) mx = fmaxf(mx, s0[i]);
#pragma unroll
            for (int i = 0; i < 16; ++i) mx = fmaxf(mx, s1[i]);
            mx = fmaxf(mx, __shfl_xor(mx, 32));
            if (__builtin_amdgcn_ballot_w64(mx > mrun + 8.0f) != 0ull) {
                asm volatile("" ::: "memory");
                const float mnew = fmaxf(mrun, mx);
                const float alpha = __builtin_amdgcn_exp2f(mrun - mnew);
                lrun *= alpha; mrun = mnew;
#pragma unroll
                for (int d = 0; d < 4; ++d)
#pragma unroll
                    for (int i = 0; i < 16; ++i) oacc[d][i] *= alpha;
            }
            float rs = 0.f;
#pragma unroll
            for (int i = 0; i < 16; ++i) { s0[i] = __builtin_amdgcn_exp2f(s0[i] - mrun); s1[i] = __builtin_amdgcn_exp2f(s1[i] - mrun); rs += s0[i] + s1[i]; }
            lrun += rs;
            bf16x8 vfr[2][4];
#define ATT_LDV(bufi, j) do { _Pragma("unroll") for (int d = 0; d < 4; ++d) { \
                const LAS unsigned char* vp = vb + (d * 32 + r) * VROWB + ((j) * 16 + hh * 4) * 2; \
                const u32x2 lo = *(const LAS u32x2*)vp, hi = *(const LAS u32x2*)(vp + 16); \
                vfr[bufi][d] = __builtin_bit_cast(bf16x8, (u32x4){lo.x, lo.y, hi.x, hi.y}); } } while (0)
            ATT_LDV(0, 0);
            __builtin_amdgcn_sched_barrier(0);
#pragma unroll
            for (int j = 0; j < 4; ++j) {
                if (j + 1 < 4) ATT_LDV((j + 1) & 1, j + 1);
                u32x4 pw;
                if (j == 0) { pw.x = pk_bf16(s0[0], s0[1]); pw.y = pk_bf16(s0[2], s0[3]); pw.z = pk_bf16(s0[4], s0[5]); pw.w = pk_bf16(s0[6], s0[7]); }
                else if (j == 1) { pw.x = pk_bf16(s0[8], s0[9]); pw.y = pk_bf16(s0[10], s0[11]); pw.z = pk_bf16(s0[12], s0[13]); pw.w = pk_bf16(s0[14], s0[15]); }
                else if (j == 2) { pw.x = pk_bf16(s1[0], s1[1]); pw.y = pk_bf16(s1[2], s1[3]); pw.z = pk_bf16(s1[4], s1[5]); pw.w = pk_bf16(s1[6], s1[7]); }
                else { pw.x = pk_bf16(s1[8], s1[9]); pw.y = pk_bf16(s1[10], s1[11]); pw.z = pk_bf16(s1[12], s1[13]); pw.w = pk_bf16(s1[14], s1[15]); }
                const bf16x8 pf = __builtin_bit_cast(bf16x8, pw);
#pragma unroll
                for (int d = 0; d < 4; ++d) oacc[d] = __builtin_amdgcn_mfma_f32_32x32x16_bf16(vfr[j & 1][d], pf, oacc[d], 0, 0, 0);
                __builtin_amdgcn_sched_barrier(0);
            }
#undef ATT_LDV
        }
        if (t + 1 < nt) ATT_WRITE(buf ^ 1);
        __syncthreads();
    }
#undef ATT_LOAD
#undef ATT_WRITE
    lrun += __shfl_xor(lrun, 32);
    const float inv = 1.0f / lrun;
    bf16_t* orow = o + (tokb + qrow) * DM + h * 128;
#pragma unroll
    for (int d = 0; d < 4; ++d)
#pragma unroll
        for (int g4 = 0; g4 < 4; ++g4) { u32x2 w; w.x = pk_bf16(oacc[d][4 * g4] * inv, oacc[d][4 * g4 + 1] * inv); w.y = pk_bf16(oacc[d][4 * g4 + 2] * inv, oacc[d][4 * g4 + 3] * inv);
            *(u32x2*)(orow + d * 32 + g4 * 8 + hh * 4) = w; }
}

__device__ __forceinline__ void attn_phase(LAS unsigned char* lds, const bf16_t* q, const bf16_t* kn, const bf16_t* kpe, const bf16_t* vt, bf16_t* o) {
    for (int pi = blockIdx.x; pi < 256; pi += gridDim.x) {
        const int bh = ((pi >> 5) << 3) | (pi & 7), x = (pi >> 3) & 3, b = bh >> 4, h = bh & 15;
        attn_block(lds, q, kn, kpe, vt, o, b, h, 7 - x);
        attn_block(lds, q, kn, kpe, vt, o, b, h, x);
    }
}

__global__ void __launch_bounds__(512, 2) yoco_megakernel(Params p) {
    extern __shared__ __attribute__((aligned(16))) unsigned char shm[];
    LAS unsigned char* lds = (LAS unsigned char*)shm;
    cg::grid_group grid = cg::this_grid();
    if (p.cg_flag) grid.sync();
    volatile LAS unsigned* xst = (volatile LAS unsigned*)(lds + 131072);
    if (threadIdx.x == 0) { xst[0] = 0u; xst[1] = 0u; xst[2] = 0u; xst[3] = 0u; }
    __syncthreads();
    const XcdBarrier xb = xcd_barrier_post(p.bar, xst);
#define GSYNC() xcd_barrier(xb)

    if constexpr (PH_MASK & 1) convert_phase(p, lds);
    if constexpr (DUP_MASK & 1) { __syncthreads(); convert_phase(p, lds); }
    GSYNC();

    const float* res = p.x;
#pragma unroll 1
    for (int layer = 0; layer < 4; ++layer) {
        const float* g0 = p.ln_g + (size_t)(layer * 2) * DM; const float* b0 = p.ln_b + (size_t)(layer * 2) * DM;
        const float* g1 = g0 + DM; const float* b1 = b0 + DM;
        const bf16_t* mixA; const bf16_t* mixW;
        if (layer < 2) {
            run_gemm<T_TOK, 6144, DM>(lds, p.hb, p.win + (size_t)layer * 6144 * DM, EpiWin{p.gb, p.vv});
            GSYNC();
            if constexpr (DUP_MASK & 32) conv_phase(p.gb, p.vv, p.conv_w + (size_t)layer * 3 * DM, p.gg);
            if constexpr (PH_MASK & 4) conv_phase(p.gb, p.vv, p.conv_w + (size_t)layer * 3 * DM, p.gg);
            GSYNC();
            mixA = p.gg; mixW = p.wout + (size_t)layer * DM * DM;
        } else {
            const int j = layer - 2;
            if (j == 0) {
                run_gemm<T_TOK, 1280, DM>(lds, p.hb, p.wdqkv, EpiF32<1280>{p.cqkv});
                GSYNC();
                if constexpr (PH_MASK & 32) norm_phase(p.cqkv, 1280, true, p.q_norm_g, p.kv_norm_g, p.cqn, p.ckv, p.kpe, p.cosT, p.sinT);
                GSYNC();
                run_gemm<T_TOK, DM, 512>(lds, p.ckv, p.wk, EpiBf16<DM>{p.kn});
                run_gemm<DM, T_TOK, 512>(lds, p.wv, p.ckv, EpiBf16<T_TOK>{p.vt});
            } else {
                {
                  pg8::Gemm g{p.hb, p.wdq3, T_TOK, 2048, 512}; pg8::StaticOrder S; S.init(T_TOK, 2048, (int)gridDim.x, (int)blockIdx.x);
                  pg8::gemm_phase<EpiBf16<2048>, 512, DM, 2>(lds, g, S, EpiBf16<2048>{(bf16_t*)p.cqkv}); }
                GSYNC();
                norm_phase_split((const bf16_t*)p.cqkv, p.q_norm_g + 512, p.cqn);
                GSYNC();
            }
            run_gemm<T_TOK, 3072, 512>(lds, p.cqn, p.wuq + (size_t)j * 3072 * 512, EpiQ{p.qb, p.cosT, p.sinT});
            GSYNC();
            if constexpr (PH_MASK & 2) attn_phase(lds, p.qb, p.kn, p.kpe, p.vt, p.ob);
            if constexpr (DUP_MASK & 2) { for (int rep = 0; rep < 2; ++rep) { __syncthreads(); attn_phase(lds, p.qb, p.kn, p.kpe, p.vt, p.ob); } }
            GSYNC();
            mixA = p.ob; mixW = p.wo + (size_t)j * DM * DM;
        }
        run_gemm<T_TOK, DM, DM>(lds, mixA, mixW, EpiZLn{p.hb, g0, b0, (float*)nullptr, p.hb, p.xbuf + (size_t)(layer * 2) * T_TOK * 8, p.lncnt + (layer * 2) * 32 * 64});
        GSYNC();
        run_gemm<T_TOK, DFF, DM>(lds, p.hb, p.w1 + (size_t)layer * DFF * DM, EpiRelu2{p.a1});
        GSYNC();
        { pg8::Gemm g{p.a1, p.w2 + (size_t)layer * DM * DFF, T_TOK, DM, DFF}; pg8::StaticOrder S; S.init(T_TOK, DM, (int)gridDim.x, (int)blockIdx.x);
          pg8::gemm_phase<EpiZLn, DFF, 256, 0, 1>(lds, g, S, EpiZLn{p.hb, g1, b1, layer < 3 ? (float*)nullptr : p.out, p.hb, p.xbuf + (size_t)(layer * 2 + 1) * T_TOK * 8, p.lncnt + (layer * 2 + 1) * 32 * 64}); }
        GSYNC();
        res = p.ha;
        if constexpr (DUP_MASK & 16) { GSYNC(); GSYNC(); GSYNC(); GSYNC(); GSYNC(); }
    }
}

extern "C" void kernel_launch(void* const* d_in, const int* in_sizes, int n_in, void* d_out, int out_size, void* d_ws, size_t ws_size, hipStream_t stream) {
    (void)in_sizes; (void)n_in; (void)out_size; (void)ws_size;
    static int grid_blocks = 0;
    if (!grid_blocks) {
        hipFuncSetAttribute((const void*)yoco_megakernel, hipFuncAttributeMaxDynamicSharedMemorySize, DYN_LDS);
        int dev = 0, cus = 0, per_cu = 0;
        hipGetDevice(&dev);
        hipDeviceGetAttribute(&cus, hipDeviceAttributeMultiprocessorCount, dev);
        hipOccupancyMaxActiveBlocksPerMultiprocessor(&per_cu, yoco_megakernel, 512, DYN_LDS);
        if (per_cu < 1) per_cu = 1;
        if (per_cu > 1) per_cu = 1;
        grid_blocks = 256;
        (void)cus;
    }
    const float* x = (const float*)d_in[0];
    const float* ln_g = (const float*)d_in[1];
    const float* ln_b = (const float*)d_in[2];
    const float* conv_w_in = (const float*)d_in[3];
    const float* conv_w = (const float*)d_in[4];
    const float* conv_w_out = (const float*)d_in[5];
    const float* kv_w_dkv = (const float*)d_in[6];
    const float* kv_norm_g = (const float*)d_in[7];
    const float* kv_w_ukv = (const float*)d_in[8];
    const float* mla_w_dq = (const float*)d_in[9];
    const float* mla_q_norm_g = (const float*)d_in[10];
    const float* mla_w_uq = (const float*)d_in[11];
    const float* mla_w_o = (const float*)d_in[12];
    const float* mlp_w1 = (const float*)d_in[13];
    const float* mlp_w2 = (const float*)d_in[14];

    Params p;
    memset(&p, 0, sizeof(p));
    p.x = x; p.ln_g = ln_g; p.ln_b = ln_b; p.conv_w = conv_w; p.kv_norm_g = kv_norm_g; p.q_norm_g = mla_q_norm_g; p.out = (float*)d_out;
    size_t off = 0;
    auto alloc = [&](size_t bytes) { void* r = (char*)d_ws + off; off += (bytes + 255) & ~(size_t)255; return r; };
    p.win = (bf16_t*)alloc((size_t)2 * 6144 * DM * 2);
    p.wout = (bf16_t*)alloc((size_t)2 * DM * DM * 2);
    p.wdqkv = (bf16_t*)alloc((size_t)1280 * DM * 2);
    p.wdq3 = (bf16_t*)alloc((size_t)512 * DM * 2);
    p.wk = (bf16_t*)alloc((size_t)DM * 512 * 2);
    p.wv = (bf16_t*)alloc((size_t)DM * 512 * 2);
    p.wuq = (bf16_t*)alloc((size_t)2 * 3072 * 512 * 2);
    p.wo = (bf16_t*)alloc((size_t)2 * DM * DM * 2);
    p.w1 = (bf16_t*)alloc((size_t)4 * DFF * DM * 2);
    p.w2 = (bf16_t*)alloc((size_t)4 * DM * DFF * 2);
    p.hb = (bf16_t*)alloc((size_t)T_TOK * DM * 2);
    p.ha = (float*)alloc((size_t)T_TOK * DM * 4);
    p.z = (float*)alloc((size_t)T_TOK * DM * 4);
    p.a1 = (bf16_t*)alloc((size_t)T_TOK * DFF * 2);
    p.gb = p.a1; p.vv = p.a1 + (size_t)T_TOK * DM; p.gg = p.a1 + (size_t)2 * T_TOK * DM;
    p.qb = p.a1; p.ob = p.a1 + (size_t)T_TOK * 3072;
    p.cqkv = (float*)alloc((size_t)T_TOK * 1280 * 4);
    p.cqn = (bf16_t*)alloc((size_t)T_TOK * 512 * 2);
    p.ckv = (bf16_t*)alloc((size_t)T_TOK * 512 * 2);
    p.kpe = (bf16_t*)alloc((size_t)T_TOK * 64 * 2);
    p.kn = (bf16_t*)alloc((size_t)T_TOK * DM * 2);
    p.vt = (bf16_t*)alloc((size_t)DM * T_TOK * 2);
    p.bar = (unsigned*)alloc((size_t)XCD_BAR_WORDS * 4);
    p.lncnt = (unsigned*)alloc((size_t)8 * 32 * 64 * 4);
    p.xbuf = (unsigned long long*)alloc((size_t)8 * T_TOK * 8 * 8);
    p.cosT = (float*)alloc((size_t)SEQ * 32 * 4);
    p.sinT = (float*)alloc((size_t)SEQ * 32 * 4);

    int nj = 0, tcount = 0;
    auto job = [&](const float* src, bf16_t* dst, int K, int pitch, int nrows, int type) { p.jobs[nj].src = src; p.jobs[nj].dst = dst; p.jobs[nj].K = K; p.jobs[nj].pitch = pitch; p.jobs[nj].ntn = nrows / 64; p.jobs[nj].type = type; p.jobs[nj].tstart = tcount; tcount += (nrows / 64) * (K / 256); ++nj; };
    for (int l = 0; l < 4; ++l) job(mlp_w1 + (size_t)l * DM * DFF, p.w1 + (size_t)l * DFF * DM, DM, DFF, DFF, 0);
    for (int l = 0; l < 4; ++l) job(mlp_w2 + (size_t)l * DFF * DM, p.w2 + (size_t)l * DM * DFF, DFF, DM, DM, 0);
    for (int l = 0; l < 2; ++l) job(conv_w_in + (size_t)l * DM * 6144, p.win + (size_t)l * 6144 * DM, DM, 6144, 6144, 1);
    for (int l = 0; l < 2; ++l) job(conv_w_out + (size_t)l * DM * DM, p.wout + (size_t)l * DM * DM, DM, DM, DM, 0);
    for (int l = 0; l < 2; ++l) job(mla_w_o + (size_t)l * DM * DM, p.wo + (size_t)l * DM * DM, DM, DM, DM, 0);
    for (int l = 0; l < 2; ++l) job(mla_w_uq + (size_t)l * 512 * 3072, p.wuq + (size_t)l * 3072 * 512, 512, 3072, 3072, 2);
    job(mla_w_dq, p.wdqkv, DM, 512, 512, 0);
    job(kv_w_dkv, p.wdqkv + (size_t)512 * DM, DM, 576, 576, 0);
    for (int sp = 0; sp < 4; ++sp) job(mla_w_dq + (size_t)DM * 512 + (size_t)sp * 512 * 512, p.wdq3 + (size_t)sp * 512 * 512, 512, 512, 512, 0);
    job(kv_w_ukv, p.wk, 512, 4096, DM, 3);
    job(kv_w_ukv, p.wv, 512, 4096, DM, 4);

    (void)hipMemsetAsync(p.bar, 0, (size_t)((char*)p.xbuf - (char*)p.bar), stream);
    void* args[] = {&p};
    hipError_t e = hipLaunchCooperativeKernel((const void*)yoco_megakernel, dim3(grid_blocks), dim3(512), args, DYN_LDS, stream);
    if (e != hipSuccess) fprintf(stderr, "cooperative launch failed: %s (grid %d)\n", hipGetErrorString(e), grid_blocks);
}
```
